# Optimizing an MI355X kernel written in HIP

```python
import math
import jax, jax.numpy as jnp
from jax import lax
import numpy as np


D_MODEL = 2048
BATCH = 16
SEQ = 2048
DEPTH = 2

HEAD_DIM = 128
MIX_WIDTH = D_MODEL // 2
N_BRANCH = 3
MOBA_HEADS = MIX_WIDTH // HEAD_DIM
MOBA_BLOCK = 256
MOBA_TOPK = 3
MOBA_Q_BLOCK = 64
DIFF_HEADS = MIX_WIDTH // (2 * HEAD_DIM)
SB_HEADS = MIX_WIDTH // HEAD_DIM
ATT_Q_BLOCK = 128
IN_COLS = 9 * MIX_WIDTH + N_BRANCH * D_MODEL
N_GROUPS = 4
EXPERTS_PER_GROUP = 8
N_EXPERTS = N_GROUPS * EXPERTS_PER_GROUP
EXPERT_FF = D_MODEL // 4
EXPERT_TOPK = 2
MOE_BLOCK = 256
RMS_EPS = 1e-6

kernel_name = 'hybrid_moba_diff_stickbreak_hmoe'


def rms_norm(x, g):
    xf = x.astype(jnp.float32)
    y = xf * lax.rsqrt(jnp.mean(xf * xf, axis=-1, keepdims=True) + RMS_EPS)
    return (y * g.astype(jnp.float32)).astype(x.dtype)


def alibi_slopes(n_heads):
    return jnp.exp2(-8.0 * jnp.arange(1, n_heads + 1, dtype=jnp.float32) / n_heads)


def split_heads(x, n_heads):
    B, S, _ = x.shape
    return x.reshape(B, S, n_heads, -1).transpose(0, 2, 1, 3)


def merge_heads(x):
    B, H, S, Dh = x.shape
    return x.transpose(0, 2, 1, 3).reshape(B, S, H * Dh)


def moba_sequence(q, k, v, slopes):
    H, S, Dh = q.shape
    scale = Dh ** -0.5
    nb = -(-S // MOBA_BLOCK)
    pad = nb * MOBA_BLOCK - S
    kp = jnp.pad(k, ((0, 0), (0, pad), (0, 0)))
    vp = jnp.pad(v, ((0, 0), (0, pad), (0, 0)))
    kb = kp.reshape(H, nb, MOBA_BLOCK, Dh)
    vb = vp.reshape(H, nb, MOBA_BLOCK, Dh)
    kmean = jnp.mean(kb.astype(jnp.float32), axis=2)
    topk = min(MOBA_TOPK, nb)
    nq = S // MOBA_Q_BLOCK
    qs = q.reshape(H, nq, MOBA_Q_BLOCK, Dh).swapaxes(0, 1)
    gather = jax.vmap(lambda blocks, idx: blocks[idx])
    r = jnp.arange(MOBA_BLOCK)

    def one_block(args):
        qi, qblk = args
        t = qi * MOBA_Q_BLOCK + jnp.arange(MOBA_Q_BLOCK)
        own = (qi * MOBA_Q_BLOCK) // MOBA_BLOCK
        gate = jnp.einsum('hqd,hnd->hqn', qblk.astype(jnp.float32), kmean)
        gate = jnp.where(jnp.arange(nb) < own, gate, -jnp.inf)
        _, sel = lax.top_k(gate, topk)
        valid = sel < own
        ksel = gather(kb, sel)
        vsel = gather(vb, sel)
        s_sel = sel[..., None] * MOBA_BLOCK + r
        lg_sel = jnp.einsum('hqd,hqkrd->hqkr', qblk, ksel).astype(jnp.float32) * scale
        lg_sel = lg_sel - slopes[:, None, None, None] * (t[None, :, None, None] - s_sel)
        lg_sel = jnp.where(valid[..., None], lg_sel, -jnp.inf).reshape(H, MOBA_Q_BLOCK, topk * MOBA_BLOCK)
        kown = lax.dynamic_slice_in_dim(kp, own * MOBA_BLOCK, MOBA_BLOCK, axis=1)
        vown = lax.dynamic_slice_in_dim(vp, own * MOBA_BLOCK, MOBA_BLOCK, axis=1)
        s_own = own * MOBA_BLOCK + r
        lg_own = jnp.einsum('hqd,hrd->hqr', qblk, kown).astype(jnp.float32) * scale
        lg_own = lg_own - slopes[:, None, None] * (t[:, None] - s_own[None, :])
        lg_own = jnp.where(s_own[None, :] <= t[:, None], lg_own, -jnp.inf)
        p = jax.nn.softmax(jnp.concatenate([lg_sel, lg_own], axis=-1), axis=-1).astype(v.dtype)
        p_sel = p[..., :topk * MOBA_BLOCK].reshape(H, MOBA_Q_BLOCK, topk, MOBA_BLOCK)
        p_own = p[..., topk * MOBA_BLOCK:]
        return (jnp.einsum('hqkr,hqkrd->hqd', p_sel, vsel)
                + jnp.einsum('hqr,hrd->hqd', p_own, vown))

    out = lax.map(one_block, (jnp.arange(nq), qs))
    return out.swapaxes(0, 1).reshape(H, S, Dh)


def diff_attention(q, k, v, lam, slopes):
    S = q.shape[3]
    scale = q.shape[-1] ** -0.5
    outs = []
    for q0 in range(0, S, ATT_Q_BLOCK):
        end = q0 + ATT_Q_BLOCK
        t = jnp.arange(q0, end)
        s = jnp.arange(end)
        lg = jnp.einsum('bhmqd,bhmkd->bhmqk', q[:, :, :, q0:end], k[:, :, :, :end]).astype(jnp.float32) * scale
        lg = lg - slopes[:, None, None, None] * (t[:, None] - s[None, :])
        lg = jnp.where(s[None, :] <= t[:, None], lg, -jnp.inf)
        p = jax.nn.softmax(lg, axis=-1)
        w = p[:, :, 0] - lam * p[:, :, 1]
        outs.append(jnp.einsum('bhqk,bhkv->bhqv', w.astype(v.dtype), v[:, :, :end]))
    return jnp.concatenate(outs, axis=2)


def stick_breaking_attention(q, k, v):
    S = q.shape[2]
    scale = q.shape[-1] ** -0.5
    outs = []
    for q0 in range(0, S, ATT_Q_BLOCK):
        end = q0 + ATT_Q_BLOCK
        t = jnp.arange(q0, end)
        s = jnp.arange(end)
        strict = s[None, :] < t[:, None]
        z = jnp.einsum('bhqd,bhkd->bhqk', q[:, :, q0:end], k[:, :, :end]).astype(jnp.float32) * scale
        log_keep = jnp.where(strict, jax.nn.log_sigmoid(-z), 0.0)
        after = lax.cumsum(log_keep, axis=3, reverse=True) - log_keep
        a = jnp.where(strict, jnp.exp(jax.nn.log_sigmoid(z) + after), 0.0)
        outs.append(jnp.einsum('bhqk,bhkd->bhqd', a.astype(v.dtype), v[:, :, :end]))
    return jnp.concatenate(outs, axis=2)


def hier_moe(h, w_rg, w_re, w_g, w_u, w_d):
    T, D = h.shape
    g_prob = jax.nn.softmax((h @ w_rg).astype(jnp.float32), axis=-1)
    g_top, g_idx = lax.top_k(g_prob, 1)
    e_logits = (h @ w_re).astype(jnp.float32).reshape(T, N_GROUPS, EXPERTS_PER_GROUP)
    e_sel = e_logits[jnp.arange(T), g_idx[:, 0]]
    e_top, e_local = lax.top_k(jax.nn.softmax(e_sel, axis=-1), EXPERT_TOPK)
    weights = g_top * e_top / jnp.sum(e_top, axis=-1, keepdims=True)
    expert = g_idx * EXPERTS_PER_GROUP + e_local
    n_assign = T * EXPERT_TOPK
    flat_e = expert.reshape(-1)
    flat_tok = jnp.arange(n_assign) // EXPERT_TOPK
    flat_w = weights.reshape(-1)
    order = jnp.argsort(flat_e)
    se = flat_e[order]
    tok_sorted = flat_tok[order]
    counts = jnp.bincount(flat_e, length=N_EXPERTS)
    padded = ((counts + MOE_BLOCK - 1) // MOE_BLOCK) * MOE_BLOCK
    pend = jnp.cumsum(padded)
    pstart = pend - padded
    cstart = jnp.cumsum(counts) - counts
    dest = pstart[se] + (jnp.arange(n_assign) - cstart[se])
    n_blocks = -(-n_assign // MOE_BLOCK) + N_EXPERTS
    xs = jnp.zeros((n_blocks * MOE_BLOCK, D), h.dtype).at[dest].set(h[tok_sorted])
    block_expert = jnp.minimum(jnp.searchsorted(pend, jnp.arange(n_blocks) * MOE_BLOCK, side='right'), N_EXPERTS - 1)

    def expert_block(args):
        xb, e = args
        return (jax.nn.silu(xb @ w_g[e]) * (xb @ w_u[e])) @ w_d[e]

    ys = lax.map(expert_block, (xs.reshape(n_blocks, MOE_BLOCK, D), block_expert)).reshape(-1, D)
    contrib = flat_w[order][:, None] * ys[dest].astype(jnp.float32)
    out = jnp.zeros((T, D), jnp.float32).at[tok_sorted].add(contrib)
    return out.astype(h.dtype)


def setup_inputs(seed: int = 0) -> dict:
    key = jax.random.key(seed)
    ks = jax.random.split(key, 22)
    L, D = DEPTH, D_MODEL

    def nrm(k, shape, scale):
        return jax.random.normal(k, shape, jnp.float32) * scale

    return {
        'x': nrm(ks[0], (BATCH, SEQ, D), 1.0),
        'attn_norm_g': 1.0 + nrm(ks[1], (L, D), 0.02),
        'w_in': nrm(ks[2], (L, D, IN_COLS), D ** -0.5),
        'gate_bias': nrm(ks[3], (L, N_BRANCH, D), 0.02),
        'moba_q_gain': 1.0 + nrm(ks[4], (L, HEAD_DIM), 0.02),
        'moba_k_gain': 1.0 + nrm(ks[5], (L, HEAD_DIM), 0.02),
        'diff_q_gain': 1.0 + nrm(ks[6], (L, HEAD_DIM), 0.02),
        'diff_k_gain': 1.0 + nrm(ks[7], (L, HEAD_DIM), 0.02),
        'diff_lambda_q1': nrm(ks[8], (L, HEAD_DIM), 0.1),
        'diff_lambda_k1': nrm(ks[9], (L, HEAD_DIM), 0.1),
        'diff_lambda_q2': nrm(ks[10], (L, HEAD_DIM), 0.1),
        'diff_lambda_k2': nrm(ks[11], (L, HEAD_DIM), 0.1),
        'diff_head_gain': 1.0 + nrm(ks[12], (L, 2 * HEAD_DIM), 0.02),
        'w_branch': nrm(ks[13], (L, N_BRANCH, MIX_WIDTH, D), MIX_WIDTH ** -0.5),
        'w_out': nrm(ks[14], (L, D, D), D ** -0.5),
        'ffn_norm_g': 1.0 + nrm(ks[15], (L, D), 0.02),
        'w_router_group': nrm(ks[16], (L, D, N_GROUPS), D ** -0.5),
        'w_router_expert': nrm(ks[17], (L, D, N_GROUPS * EXPERTS_PER_GROUP), D ** -0.5),
        'w_expert_gate': nrm(ks[18], (L, N_EXPERTS, D, EXPERT_FF), D ** -0.5),
        'w_expert_up': nrm(ks[19], (L, N_EXPERTS, D, EXPERT_FF), D ** -0.5),
        'w_expert_down': nrm(ks[20], (L, N_EXPERTS, EXPERT_FF, D), EXPERT_FF ** -0.5),
    }


def reference(x, attn_norm_g, w_in, gate_bias, moba_q_gain, moba_k_gain, diff_q_gain, diff_k_gain,
              diff_lambda_q1, diff_lambda_k1, diff_lambda_q2, diff_lambda_k2, diff_head_gain,
              w_branch, w_out, ffn_norm_g, w_router_group, w_router_expert,
              w_expert_gate, w_expert_up, w_expert_down):
    B, S, D = x.shape
    slopes_moba = alibi_slopes(MOBA_HEADS)
    slopes_diff = alibi_slopes(DIFF_HEADS)
    for l in range(DEPTH):
        h = rms_norm(x, attn_norm_g[l])
        proj = h @ w_in[l]
        mix = proj[..., :9 * MIX_WIDTH].reshape(B, S, N_BRANCH, 3, MIX_WIDTH)
        gate_logits = proj[..., 9 * MIX_WIDTH:].reshape(B, S, N_BRANCH, D)

        qa = rms_norm(split_heads(mix[:, :, 0, 0], MOBA_HEADS), moba_q_gain[l])
        ka = rms_norm(split_heads(mix[:, :, 0, 1], MOBA_HEADS), moba_k_gain[l])
        va = split_heads(mix[:, :, 0, 2], MOBA_HEADS)
        oa = lax.map(lambda qkv: moba_sequence(qkv[0], qkv[1], qkv[2], slopes_moba), (qa, ka, va))

        qb = rms_norm(mix[:, :, 1, 0].reshape(B, S, DIFF_HEADS, 2, HEAD_DIM).transpose(0, 2, 3, 1, 4), diff_q_gain[l])
        kb = rms_norm(mix[:, :, 1, 1].reshape(B, S, DIFF_HEADS, 2, HEAD_DIM).transpose(0, 2, 3, 1, 4), diff_k_gain[l])
        vb = split_heads(mix[:, :, 1, 2], DIFF_HEADS)
        lam_init = 0.8 - 0.6 * math.exp(-0.3 * l)
        lam = (jnp.exp(jnp.sum(diff_lambda_q1[l].astype(jnp.float32) * diff_lambda_k1[l].astype(jnp.float32)))
               - jnp.exp(jnp.sum(diff_lambda_q2[l].astype(jnp.float32) * diff_lambda_k2[l].astype(jnp.float32)))
               + lam_init)
        ob = diff_attention(qb, kb, vb, lam, slopes_diff)
        ob = rms_norm(ob, diff_head_gain[l]) * (1.0 - lam_init)

        qc = split_heads(mix[:, :, 2, 0], SB_HEADS)
        kc = split_heads(mix[:, :, 2, 1], SB_HEADS)
        vc = split_heads(mix[:, :, 2, 2], SB_HEADS)
        oc = stick_breaking_attention(qc, kc, vc)

        branches = jnp.stack([merge_heads(oa), merge_heads(ob), merge_heads(oc)], axis=2)
        branch_out = jnp.einsum('bsgc,gcd->bsgd', branches, w_branch[l])
        gates = jax.nn.sigmoid(gate_logits + gate_bias[l])
        mixed = jnp.sum(gates * branch_out, axis=2)
        x = x + mixed @ w_out[l]

        h = rms_norm(x, ffn_norm_g[l])
        y = hier_moe(h.reshape(B * S, D), w_router_group[l], w_router_expert[l],
                     w_expert_gate[l], w_expert_up[l], w_expert_down[l])
        x = x + y.reshape(B, S, D)
    return x
```

```cpp
#include <hip/hip_runtime.h>
#include <cstdio>
#include <cstdint>

#define LAS __attribute__((address_space(3)))
typedef unsigned short bf16_t;
typedef short bf16x8 __attribute__((ext_vector_type(8)));
typedef short s16x4 __attribute__((ext_vector_type(4)));
typedef float f32x4 __attribute__((ext_vector_type(4)));
typedef float f32x2 __attribute__((ext_vector_type(2)));
typedef float f32x16 __attribute__((ext_vector_type(16)));
typedef unsigned u32x4 __attribute__((ext_vector_type(4)));
typedef unsigned u32x2 __attribute__((ext_vector_type(2)));
typedef __bf16 bf16x2_t __attribute__((ext_vector_type(2)));

constexpr int D = 2048, BATCH = 16, SEQ = 2048, DEPTH = 2, NTOK = BATCH * SEQ;
constexpr int HD = 128, MIXW = 1024, INC = 9 * MIXW + 3 * D;
constexpr int NEXP = 32, FF = 512, NASSIGN = NTOK * 2;
constexpr int CHB = 8, CHT = CHB * SEQ, NCH = BATCH / CHB;
constexpr int MAXTILES = NASSIGN / 256 + NEXP, MAXSLOTS = MAXTILES * 256;
constexpr float RMS_EPS = 1e-6f;
constexpr float QSCALE2 = 0.08838834764831845f * 1.4426950408889634f;

constexpr size_t MiB = 1u << 20;
constexpr size_t WS_CTL = 0, CTL_BYTES = 4 * MiB;
constexpr size_t WS_WIN = 4 * MiB, WS_WBR = 64 * MiB, WS_WOUT = 76 * MiB, WS_WGU = 84 * MiB, WS_WD = 212 * MiB;
constexpr size_t WS_H = 276 * MiB;
constexpr size_t WS_R = 404 * MiB;
constexpr size_t WS_PROJ = WS_R, WS_VT = WS_R + 480 * MiB, WS_BR = WS_R + 576 * MiB, WS_MIXF = WS_R + 672 * MiB, WS_MIXB = WS_R + 800 * MiB, WS_KMEAN = WS_R + 864 * MiB;
constexpr size_t WS_XS = WS_R, WS_ACT = WS_R + 288 * MiB, WS_Y = WS_R + 360 * MiB, WS_ROUT = WS_R + 648 * MiB;
constexpr size_t WS_END = WS_R + 866 * MiB;
constexpr size_t RO_E = 0, RO_W = 1 * MiB, RO_POS = 2 * MiB, RO_SLOT = 3 * MiB, RO_TILE = 4 * MiB;
constexpr int CW_BAR = 0;
constexpr int CW_WQ = 4096;
constexpr int CW_CNT = 8192;
constexpr int CW_FLAG = 16384;

__device__ __forceinline__ unsigned pk2(float lo, float hi) { f32x2 v = {lo, hi}; bf16x2_t b = __builtin_convertvector(v, bf16x2_t); return __builtin_bit_cast(unsigned, b); }
__device__ __forceinline__ float bf2f(unsigned short b) { return __uint_as_float(((unsigned)b) << 16); }
__device__ __forceinline__ float bflo(unsigned w) { return __uint_as_float(w << 16); }
__device__ __forceinline__ float bfhi(unsigned w) { return __uint_as_float(w & 0xffff0000u); }
__device__ __forceinline__ float wave_sum(float v) {
#pragma unroll
    for (int o = 1; o < 64; o <<= 1) v += __shfl_xor(v, o);
    return v;
}
__device__ __forceinline__ float wave_max(float v) {
#pragma unroll
    for (int o = 1; o < 64; o <<= 1) v = fmaxf(v, __shfl_xor(v, o));
    return v;
}
__device__ __forceinline__ float fast_exp2(float x) { return __builtin_amdgcn_exp2f(x); }
__device__ __forceinline__ float fast_rcp(float x) { return __builtin_amdgcn_rcpf(x); }
__device__ __forceinline__ float sigmoidf_(float x) { return fast_rcp(1.0f + fast_exp2(-1.4426950408889634f * x)); }
__device__ __forceinline__ int fresh_tid() { int t = threadIdx.x; asm volatile("" : "+v"(t)); return t; }
template <class T> __device__ __forceinline__ T* fresh_ptr(T* p) { asm volatile("" : "+s"(p)); return p; }
__device__ __forceinline__ float uniformf(float v) { return __uint_as_float(__builtin_amdgcn_readfirstlane(__float_as_uint(v))); }
#define LDS_WAIT() asm volatile("s_waitcnt lgkmcnt(0)" ::: "memory")
#define VM_WAIT() asm volatile("s_waitcnt vmcnt(0)" ::: "memory")

#define XB_TMO      128
#define XB_XCNT(j)  (256  + 64 * (j))
#define XB_XSUB(j)  (1280 + 64 * (j))
#define XB_XGEN(j)  (2304 + 64 * (j))
#define XB_TOP      3328
#define XB_TOPGEN   3392
#define XCD_BAR_WORDS 3456
#define XB_SPIN_CAP (1u << 24)
__device__ __forceinline__ unsigned xb_ld(unsigned* p)              { return __hip_atomic_load(p, __ATOMIC_RELAXED, __HIP_MEMORY_SCOPE_AGENT); }
__device__ __forceinline__ unsigned xb_add(unsigned* p, unsigned v) { return __hip_atomic_fetch_add(p, v, __ATOMIC_RELAXED, __HIP_MEMORY_SCOPE_AGENT); }
__device__ __forceinline__ unsigned xb_xcc_id() { return (unsigned)__builtin_amdgcn_s_getreg((3 << 11) | 20) & 0xFu; }
#define XB_SPIN(cond, bar) do { unsigned _sp = 0; while (cond) { __builtin_amdgcn_s_sleep(1); \
    if ((++_sp & 255u) == 0u) { if (xb_ld(&(bar)[XB_TMO])) break; if (_sp > XB_SPIN_CAP) { atomicAdd(&(bar)[XB_TMO], 1u); break; } } } } while (0)
struct XcdBarrier { unsigned* bar; unsigned x; volatile LAS unsigned* st; };
__device__ __forceinline__ XcdBarrier xcd_barrier_post(unsigned* bar, volatile LAS unsigned* st) {
    XcdBarrier b; b.bar = bar; b.x = xb_xcc_id(); b.st = st;
    if (threadIdx.x == 0) (void)xb_add(&bar[XB_XCNT(b.x)], 1u);
    return b;
}
__device__ __forceinline__ void xcd_barrier_complete(unsigned* bar, unsigned x, unsigned& nloc, unsigned& nx) {
    const unsigned G = gridDim.x * gridDim.y * gridDim.z;
    unsigned sum, cnt, mine, sp = 0u;
    for (;;) {
        sum = 0u; cnt = 0u; mine = 0u;
#pragma unroll
        for (unsigned j = 0; j < 16; ++j) { const unsigned c = xb_ld(&bar[XB_XCNT(j)]); sum += c; cnt += (c > 0u) ? 1u : 0u; mine = (j == x) ? c : mine; }
        if (sum == G) break;
        __builtin_amdgcn_s_sleep(1);
        if ((++sp & 255u) == 0u) { if (xb_ld(&bar[XB_TMO])) break; if (sp > XB_SPIN_CAP) { atomicAdd(&bar[XB_TMO], 1u); break; } }
    }
    nloc = mine > 0u ? mine : 1u; nx = cnt > 0u ? cnt : 1u;
}
__device__ __forceinline__ void xcd_barrier(const XcdBarrier& b) {
    asm volatile("s_waitcnt vmcnt(0)" ::: "memory");
    __syncthreads();
    if (threadIdx.x == 0) {
        unsigned* bar = b.bar;
        __builtin_amdgcn_s_waitcnt(0);
        unsigned nloc = b.st[0], nx = b.st[1];
        if (nloc == 0u) { xcd_barrier_complete(bar, b.x, nloc, nx); b.st[0] = nloc; b.st[1] = nx; }
        const unsigned old = xb_add(&bar[XB_XSUB(b.x)], 1u);
        const unsigned gen = old / nloc;
        if (old + 1u == (gen + 1u) * nloc) {
            __builtin_amdgcn_fence(__ATOMIC_RELEASE, "agent");
            asm volatile("s_waitcnt vmcnt(0)" ::: "memory");
            const unsigned og = xb_add(&bar[XB_TOP], 1u);
            const unsigned tg = og / nx;
            if (og + 1u == (tg + 1u) * nx) xb_add(&bar[XB_TOPGEN], 1u);
            else XB_SPIN(xb_ld(&bar[XB_TOPGEN]) == tg, bar);
            __builtin_amdgcn_fence(__ATOMIC_ACQUIRE, "agent");
            xb_add(&bar[XB_XGEN(b.x)], 1u);
            asm volatile("s_waitcnt vmcnt(0)" ::: "memory");
        } else {
            XB_SPIN(xb_ld(&bar[XB_XGEN(b.x)]) == gen, bar);
            __builtin_amdgcn_fence(__ATOMIC_ACQUIRE, "agent");
            asm volatile("s_waitcnt vmcnt(0)" ::: "memory");
        }
    }
    __syncthreads();
}

namespace pg8 {
constexpr int BM = 256, BK = 64, HALF = 128, HTB = HALF * BK * 2, STAGE_BYTES = 8 * HTB, NXCD = 8, WGM = 8;
__host__ __device__ __forceinline__ int lds_byte(int r, int c) { const int st = (r >> 4) * 2 + (c >> 5), rr = r & 15, cc = c & 31, ob = rr * 64 + cc * 2; return st * 1024 + (ob ^ (((ob >> 9) & 1) << 5)); }
__host__ __device__ __forceinline__ void stage_rc(int b, int& R, int& C) { const int st = b / 1024, sb = b % 1024, swz = sb ^ (((sb >> 9) & 1) << 5); R = (st >> 1) * 16 + swz / 64; C = (st & 1) * 32 + (swz % 64) / 2; }
__host__ __device__ __forceinline__ int perm32(int rho) { const int n = rho >> 4, i = rho & 15; return 8 * (i >> 2) + 4 * n + (i & 3); }

struct Unit { int pm, pn, be; };
struct Gemm { const bf16_t* A; const bf16_t* Bt; int lda, ldb, K; size_t bstride; };

struct StaticOrder {
    int nM, nN, nwg, G, c;
    __device__ void init(int M, int N, int G_, int c_) { nM = M / BM; nN = N / BM; nwg = nM * nN; G = G_; c = c_; }
    __device__ bool next(int i, Unit& u) const {
        const long L = (long)i * G + c; if (L >= nwg) return false;
        int wgid = (int)L; { const int q = nwg / NXCD, r = nwg % NXCD, xcd = wgid % NXCD, off = wgid / NXCD; wgid = (xcd < r ? xcd * (q + 1) : r * (q + 1) + (xcd - r) * q) + off; }
        const int nig = WGM * nN, gid = wgid / nig, fm = gid * WGM, gsz = (nM - fm) < WGM ? (nM - fm) : WGM;
        u.pm = fm + ((wgid % nig) % gsz); u.pn = (wgid % nig) / gsz; u.be = 0; return true;
    }
};
struct MoeOrder : StaticOrder {
    const int* tile_expert;
    __device__ bool next(int i, Unit& u) const {
        if (!StaticOrder::next(i, u)) return false;
        u.be = __builtin_amdgcn_readfirstlane(tile_expert[u.pm]); return true;
    }
};

template <class Epi, class Sched, bool ALIGN_EPI>
__device__ __forceinline__ void gemm_phase(LAS unsigned char* lds, const Gemm g, const Sched& S, const Epi& E) {
    const int tid = fresh_tid(), wid = __builtin_amdgcn_readfirstlane(tid >> 6), lane = tid & 63, wr = wid >> 2, wc = wid & 3, fr = lane & 15, fq = lane >> 4;
    const int K = g.K, nt = K / BK;
    unsigned voffA[2], voffB[2];
#pragma unroll
    for (int i = 0; i < 2; ++i) { int R, C; stage_rc(tid * 16 + i * 8192, R, C); const int Rb = Epi::PERM ? ((R & ~31) + perm32(R & 31)) : R;
        voffA[i] = (unsigned)(R * g.lda + C) * 2u; voffB[i] = (unsigned)(Rb * g.ldb + C) * 2u; }
    const size_t kstep = (size_t)(BK * 2);
    const size_t hsA = (size_t)HALF * g.lda * 2, hsB = (size_t)HALF * g.ldb * 2;
    const unsigned ldsw = (unsigned)wid * 1024u;
    const int aoff = lds_byte(wr * 64 + fr, fq * 8), boff = lds_byte(wc * 32 + fr, fq * 8);
#define PG8_SA(b, h) (((b) * 2 + (h)) * HTB)
#define PG8_SB(b, h) ((4 + (b) * 2 + (h)) * HTB)
#define PG8_STAGE(bufoff, gbase, voff) do { _Pragma("unroll") for (int _i = 0; _i < 2; ++_i) \
        __builtin_amdgcn_global_load_lds((const unsigned*)((const char*)(gbase) + (voff)[_i]), (LAS unsigned*)(lds + (bufoff) + ldsw + _i * 8192), 16, 0, 0); } while (0)
#define PG8_LDA(dst, b, h) do { _Pragma("unroll") for (int m = 0; m < 4; ++m) _Pragma("unroll") for (int k = 0; k < 2; ++k) dst[m][k] = *(const LAS bf16x8*)(lds + PG8_SA(b, h) + aoff + m * 2048 + k * 1024); } while (0)
#define PG8_LDB(dst, b, h) do { _Pragma("unroll") for (int n = 0; n < 2; ++n) _Pragma("unroll") for (int k = 0; k < 2; ++k) dst[n][k] = *(const LAS bf16x8*)(lds + PG8_SB(b, h) + boff + n * 2048 + k * 1024); } while (0)
#define PG8_MMA(ai, bj, At, Bt) do { __builtin_amdgcn_s_setprio(1); _Pragma("unroll") for (int m = 0; m < 4; ++m) _Pragma("unroll") for (int n = 0; n < 2; ++n) _Pragma("unroll") for (int k = 0; k < 2; ++k) \
        acc[ai][bj][m][n] = __builtin_amdgcn_mfma_f32_16x16x32_bf16(Bt[n][k], At[m][k], acc[ai][bj][m][n], 0, 0, 0); __builtin_amdgcn_s_setprio(0); } while (0)
#define PG8_WAIT_V(n) asm volatile("s_waitcnt vmcnt(" #n ")" ::: "memory")
#define PG8_WAIT_L(n) asm volatile("s_waitcnt lgkmcnt(" #n ")" ::: "memory")
#define PG8_BAR __builtin_amdgcn_s_barrier()
#define PG8_SCHED __builtin_amdgcn_sched_barrier(0)
    Unit cur, nxt; int ui = 0;
    if (!S.next(0, cur)) return;
    f32x4 acc[2][2][4][2];
#pragma unroll
    for (int a = 0; a < 2; ++a)
#pragma unroll
        for (int b = 0; b < 2; ++b)
#pragma unroll
            for (int m = 0; m < 4; ++m)
#pragma unroll
                for (int n = 0; n < 2; ++n) acc[a][b][m][n] = (f32x4){0.f, 0.f, 0.f, 0.f};
    bf16x8 At[4][2], B0[2][2], B1[2][2];
    const char* cA = (const char*)g.A + (size_t)cur.pm * 2 * hsA; const char* cB = (const char*)g.Bt + ((size_t)cur.be * g.bstride) * 2 + (size_t)cur.pn * 2 * hsB;
    PG8_STAGE(PG8_SB(0, 0), cB, voffB); PG8_STAGE(PG8_SB(0, 1), cB + hsB, voffB); PG8_STAGE(PG8_SA(0, 0), cA, voffA); PG8_STAGE(PG8_SA(0, 1), cA + hsA, voffA);
    if (wr == 1) PG8_BAR;
    PG8_WAIT_V(2); PG8_BAR;
    PG8_STAGE(PG8_SB(1, 0), cB + kstep, voffB); PG8_STAGE(PG8_SA(1, 0), cA + kstep, voffA); PG8_STAGE(PG8_SB(1, 1), cB + hsB + kstep, voffB);
    PG8_WAIT_V(6); PG8_BAR;
    for (;;) {
        const bool has_next = S.next(ui + 1, nxt);
        const char* nA = has_next ? (const char*)g.A + (size_t)nxt.pm * 2 * hsA : cA;
        const char* nB = has_next ? (const char*)g.Bt + ((size_t)nxt.be * g.bstride) * 2 + (size_t)nxt.pn * 2 * hsB : cB;
        for (int t = 0; t < nt; t += 2) {
            const bool last = (t == nt - 2);
            const char* a1 = cA + (size_t)(t + 1) * kstep;
            const char* a2 = last ? nA : cA + (size_t)(t + 2) * kstep; const char* b2 = last ? nB : cB + (size_t)(t + 2) * kstep;
            const char* a3 = a2 + kstep; const char* b3 = b2 + kstep;
            PG8_LDB(B0, 0, 0); PG8_LDB(B1, 0, 1); PG8_SCHED; PG8_LDA(At, 0, 0); PG8_STAGE(PG8_SA(1, 1), a1 + hsA, voffA);
            PG8_WAIT_V(8); PG8_WAIT_L(0); PG8_BAR; PG8_MMA(0, 0, At, B0); PG8_MMA(0, 1, At, B1); PG8_BAR; PG8_SCHED;
            PG8_LDA(At, 0, 1); PG8_STAGE(PG8_SB(0, 0), b2, voffB); PG8_STAGE(PG8_SB(0, 1), b2 + hsB, voffB); PG8_STAGE(PG8_SA(0, 0), a2, voffA);
            PG8_WAIT_V(8); PG8_WAIT_L(0); PG8_BAR; PG8_MMA(1, 0, At, B0); PG8_MMA(1, 1, At, B1); PG8_BAR; PG8_SCHED;
            PG8_LDB(B0, 1, 0); PG8_LDB(B1, 1, 1); PG8_SCHED; PG8_LDA(At, 1, 0); PG8_STAGE(PG8_SA(0, 1), a2 + hsA, voffA);
            PG8_WAIT_V(8); PG8_WAIT_L(0); PG8_BAR; PG8_MMA(0, 0, At, B0); PG8_MMA(0, 1, At, B1); PG8_BAR; PG8_SCHED;
            PG8_LDA(At, 1, 1); PG8_STAGE(PG8_SB(1, 0), b3, voffB); PG8_STAGE(PG8_SB(1, 1), b3 + hsB, voffB); PG8_STAGE(PG8_SA(1, 0), a3, voffA);
            PG8_WAIT_V(8); PG8_WAIT_L(0); PG8_BAR; PG8_MMA(1, 0, At, B0); PG8_MMA(1, 1, At, B1); PG8_BAR; PG8_SCHED;
        }
        if constexpr (ALIGN_EPI) { if (wr == 0) PG8_BAR; }
        E(acc, cur, wr, wc, fr, fq);
        if (!has_next) break;
#pragma unroll
        for (int a = 0; a < 2; ++a)
#pragma unroll
            for (int b = 0; b < 2; ++b)
#pragma unroll
                for (int m = 0; m < 4; ++m)
#pragma unroll
                    for (int n = 0; n < 2; ++n) acc[a][b][m][n] = (f32x4){0.f, 0.f, 0.f, 0.f};
        cur = nxt; cA = nA; cB = nB; ++ui;
        if constexpr (ALIGN_EPI) { if (wr == 1) PG8_BAR; }
    }
    PG8_WAIT_V(0);
    if constexpr (!ALIGN_EPI) { if (wr == 0) PG8_BAR; }
    PG8_BAR;
#undef PG8_SA
#undef PG8_SB
#undef PG8_STAGE
#undef PG8_LDA
#undef PG8_LDB
#undef PG8_MMA
#undef PG8_WAIT_V
#undef PG8_WAIT_L
#undef PG8_BAR
#undef PG8_SCHED
}

struct EpiBf16Plain {
    static constexpr bool PERM = true;
    bf16_t* O; int ldc;
    __device__ __forceinline__ void operator()(const f32x4 (&acc)[2][2][4][2], const Unit& u, int wr, int wc, int fr, int fq) const {
        const int row0 = u.pm * BM + wr * 64 + fr; const int col0 = u.pn * BM + wc * 32 + 8 * fq;
#pragma unroll
        for (int ai = 0; ai < 2; ++ai)
#pragma unroll
            for (int m = 0; m < 4; ++m) { bf16_t* rowp = O + (size_t)(row0 + ai * HALF + m * 16) * ldc + col0;
#pragma unroll
                for (int bj = 0; bj < 2; ++bj) { const f32x4 v0 = acc[ai][bj][m][0], v1 = acc[ai][bj][m][1];
                    u32x4 w; w.x = pk2(v0[0], v0[1]); w.y = pk2(v0[2], v0[3]); w.z = pk2(v1[0], v1[1]); w.w = pk2(v1[2], v1[3]);
                    *(u32x4*)(rowp + bj * HALF) = w; } }
    }
};
struct EpiGate {
    static constexpr bool PERM = false;
    const bf16_t* gate; int ldg; const float* gbias; float* mixf; bf16_t* mixb; int pass;
    __device__ __forceinline__ void operator()(const f32x4 (&acc)[2][2][4][2], const Unit& u, int wr, int wc, int fr, int fq) const {
        const int row0 = u.pm * BM + wr * 64 + fr, col0 = u.pn * BM + wc * 32 + 4 * fq;
        f32x4 bv[2][2];
#pragma unroll
        for (int bj = 0; bj < 2; ++bj)
#pragma unroll
            for (int n = 0; n < 2; ++n) bv[bj][n] = *(const f32x4*)(gbias + col0 + bj * HALF + n * 16);
#pragma unroll
        for (int ai = 0; ai < 2; ++ai)
#pragma unroll
            for (int m = 0; m < 4; ++m) { const size_t row = (size_t)(row0 + ai * HALF + m * 16);
#pragma unroll
                for (int bj = 0; bj < 2; ++bj)
#pragma unroll
                    for (int n = 0; n < 2; ++n) { const int col = col0 + bj * HALF + n * 16;
                        const u32x2 gw = *(const u32x2*)(gate + row * ldg + col);
                        f32x4 gl = {bflo(gw.x), bfhi(gw.x), bflo(gw.y), bfhi(gw.y)}; gl = gl + bv[bj][n];
                        f32x4 v = acc[ai][bj][m][n];
                        v[0] *= sigmoidf_(gl[0]); v[1] *= sigmoidf_(gl[1]); v[2] *= sigmoidf_(gl[2]); v[3] *= sigmoidf_(gl[3]);
                        float* mp = mixf + row * D + col;
                        if (pass > 0) v = v + *(const f32x4*)mp;
                        if (pass < 2) *(f32x4*)mp = v;
                        else { u32x2 o; o.x = pk2(v[0], v[1]); o.y = pk2(v[2], v[3]); *(u32x2*)(mixb + row * D + col) = o; } }
                asm volatile("" ::: "memory"); }
    }
};
struct EpiResid {
    static constexpr bool PERM = false;
    const float* base; float* out;
    __device__ __forceinline__ void operator()(const f32x4 (&acc)[2][2][4][2], const Unit& u, int wr, int wc, int fr, int fq) const {
        const int row0 = u.pm * BM + wr * 64 + fr, col0 = u.pn * BM + wc * 32 + 4 * fq;
#pragma unroll
        for (int ai = 0; ai < 2; ++ai)
#pragma unroll
            for (int m = 0; m < 4; ++m) { const size_t off = (size_t)(row0 + ai * HALF + m * 16) * D + col0;
#pragma unroll
                for (int bj = 0; bj < 2; ++bj)
#pragma unroll
                    for (int n = 0; n < 2; ++n) { const f32x4 bs = *(const f32x4*)(base + off + bj * HALF + n * 16); *(f32x4*)(out + off + bj * HALF + n * 16) = bs + acc[ai][bj][m][n]; }
                asm volatile("" ::: "memory"); }
    }
};
struct EpiSwiglu {
    static constexpr bool PERM = true;
    bf16_t* act;
    __device__ __forceinline__ void operator()(const f32x4 (&acc)[2][2][4][2], const Unit& u, int wr, int wc, int fr, int fq) const {
        const int row0 = u.pm * BM + wr * 64 + fr; const int col0 = u.pn * BM + wc * 32 + 8 * fq;
#pragma unroll
        for (int ai = 0; ai < 2; ++ai)
#pragma unroll
            for (int m = 0; m < 4; ++m) { bf16_t* rowp = act + (size_t)(row0 + ai * HALF + m * 16) * FF + (col0 >> 1);
#pragma unroll
                for (int bj = 0; bj < 2; ++bj) { const f32x4 v0 = acc[ai][bj][m][0], v1 = acc[ai][bj][m][1];
                    const float a0 = v0[0] * sigmoidf_(v0[0]) * v0[1], a1 = v0[2] * sigmoidf_(v0[2]) * v0[3];
                    const float a2 = v1[0] * sigmoidf_(v1[0]) * v1[1], a3 = v1[2] * sigmoidf_(v1[2]) * v1[3];
                    u32x2 o; o.x = pk2(a0, a1); o.y = pk2(a2, a3);
                    *(u32x2*)(rowp + bj * (HALF / 2)) = o; } }
    }
};
}
constexpr int NWAVES = 8, NTHR = 512;
constexpr int RING_BYTES = 131072;
constexpr int MISC_OFF = RING_BYTES;
constexpr int LDS_BYTES = 147456;

struct Args {
    const float* x; const float* attn_norm_g; const float* w_in; const float* gate_bias;
    const float* moba_q_gain; const float* moba_k_gain; const float* diff_q_gain; const float* diff_k_gain;
    const float* lq1; const float* lk1; const float* lq2; const float* lk2; const float* diff_head_gain;
    const float* w_branch; const float* w_out; const float* ffn_norm_g; const float* w_rg; const float* w_re;
    const float* w_eg; const float* w_eu; const float* w_ed;
    float* out; unsigned char* ws;
    int step_lo, step_hi;
};

typedef const __attribute__((address_space(4))) Args* KArgs;
__device__ __forceinline__ KArgs fresh_args(KArgs p) { asm volatile("" : "+s"(p)); return p; }

struct Frame {
    LAS unsigned char* lds; volatile LAS unsigned* MISC; unsigned* ctl;
    int tid, lane, wave, G, bid;
};

__device__ __forceinline__ void wconv_item(const float* W, int K, int N, bf16_t* WT, int row_off, int row_mul, LAS float* scr, int item, int lane) {
    const int nblk = N / 32, kb = item / nblk, nb = item % nblk, k0 = 64 * kb, n0 = 32 * nb;
#pragma unroll 8
    for (int i = 0; i < 32; ++i) { const int kk = 2 * i + (lane >> 5); scr[kk * 33 + (lane & 31)] = W[(size_t)(k0 + kk) * N + n0 + (lane & 31)]; }
    LDS_WAIT(); asm volatile("" ::: "memory");
    const int c = lane & 7;
#pragma unroll
    for (int j = 0; j < 4; ++j) { const int n = (lane >> 3) + 8 * j; const LAS float* s = scr + (8 * c) * 33 + n;
        u32x4 o; o.x = pk2(s[0 * 33], s[1 * 33]); o.y = pk2(s[2 * 33], s[3 * 33]); o.z = pk2(s[4 * 33], s[5 * 33]); o.w = pk2(s[6 * 33], s[7 * 33]);
        *(u32x4*)(WT + (size_t)(row_off + (n0 + n) * row_mul) * K + k0 + 8 * c) = o; }
    LDS_WAIT(); asm volatile("" ::: "memory");
}
__device__ __forceinline__ void phase_wconv(const Frame& F0, KArgs a0, int layer) {
    Frame F = F0; F.tid = fresh_tid(); F.lane = F.tid & 63; F.wave = __builtin_amdgcn_readfirstlane(F.tid >> 6); const KArgs a = fresh_args(a0); unsigned char* const ws_ = a->ws; F.ctl = (unsigned*)(ws_ + WS_CTL);
    LAS float* scr = (LAS float*)(F.lds + F.wave * 16384);
    unsigned char* ws = ws_;
    bf16_t* win_t = (bf16_t*)(ws + WS_WIN); bf16_t* wbr_t = (bf16_t*)(ws + WS_WBR); bf16_t* wout_t = (bf16_t*)(ws + WS_WOUT);
    bf16_t* wgu_t = (bf16_t*)(ws + WS_WGU); bf16_t* wd_t = (bf16_t*)(ws + WS_WD);
    constexpr int I_IN = (D / 64) * (INC / 32), I_BR = (MIXW / 64) * (D / 32), I_OUT = (D / 64) * (D / 32), I_G = (D / 64) * (FF / 32), I_D = (FF / 64) * (D / 32);
    constexpr int NITEMS = I_IN + 3 * I_BR + I_OUT + 2 * NEXP * I_G + NEXP * I_D;
    const int gw = F.bid * NWAVES + F.wave, NGW = F.G * NWAVES;
    for (int it = gw; it < NITEMS; it += NGW) {
        int r = it;
        if (r < I_IN) { wconv_item(a->w_in + (size_t)layer * D * INC, D, INC, win_t, 0, 1, scr, r, F.lane); continue; } r -= I_IN;
        if (r < 3 * I_BR) { const int g = r / I_BR; wconv_item(a->w_branch + (size_t)(layer * 3 + g) * MIXW * D, MIXW, D, wbr_t + (size_t)g * D * MIXW, 0, 1, scr, r % I_BR, F.lane); continue; } r -= 3 * I_BR;
        if (r < I_OUT) { wconv_item(a->w_out + (size_t)layer * D * D, D, D, wout_t, 0, 1, scr, r, F.lane); continue; } r -= I_OUT;
        if (r < NEXP * I_G) { const int e = r / I_G; wconv_item(a->w_eg + (size_t)(layer * NEXP + e) * D * FF, D, FF, wgu_t + (size_t)e * 2 * FF * D, 0, 2, scr, r % I_G, F.lane); continue; } r -= NEXP * I_G;
        if (r < NEXP * I_G) { const int e = r / I_G; wconv_item(a->w_eu + (size_t)(layer * NEXP + e) * D * FF, D, FF, wgu_t + (size_t)e * 2 * FF * D, 1, 2, scr, r % I_G, F.lane); continue; } r -= NEXP * I_G;
        { const int e = r / I_D; wconv_item(a->w_ed + (size_t)(layer * NEXP + e) * FF * D, FF, D, wd_t + (size_t)e * D * FF, 0, 1, scr, r % I_D, F.lane); }
    }
}

__device__ __forceinline__ void rms_row_to_bf16(const f32x4 (&v)[8], const float* gain, bf16_t* orow, int lane) {
    float s = 0.f;
#pragma unroll
    for (int j = 0; j < 8; ++j) s += (v[j].x * v[j].x + v[j].y * v[j].y) + (v[j].z * v[j].z + v[j].w * v[j].w);
    const float rstd = 1.0f / sqrtf(wave_sum(s) * (1.f / D) + RMS_EPS);
    u32x2* o8 = (u32x2*)orow + lane;
#pragma unroll
    for (int j = 0; j < 8; ++j) { const f32x4 g = *((const f32x4*)gain + lane + 64 * j); u32x2 o; o.x = pk2(v[j].x * rstd * g.x, v[j].y * rstd * g.y); o.y = pk2(v[j].z * rstd * g.z, v[j].w * rstd * g.w); o8[64 * j] = o; }
}
__device__ __forceinline__ void phase_norm0(const Frame& F0, KArgs a0) {
    Frame F = F0; F.tid = fresh_tid(); F.lane = F.tid & 63; F.wave = __builtin_amdgcn_readfirstlane(F.tid >> 6); const KArgs a = fresh_args(a0); unsigned char* const ws_ = a->ws; F.ctl = (unsigned*)(ws_ + WS_CTL);
    bf16_t* H = (bf16_t*)(ws_ + WS_H);
    const int gw = F.bid * NWAVES + F.wave, NGW = F.G * NWAVES;
    for (int m = gw; m < NTOK; m += NGW) {
        const f32x4* xr = (const f32x4*)(a->x + (size_t)m * D) + F.lane; f32x4 v[8];
#pragma unroll
        for (int j = 0; j < 8; ++j) v[j] = xr[64 * j];
        rms_row_to_bf16(v, a->attn_norm_g, H + (size_t)m * D, F.lane);
    }
}

__device__ __forceinline__ void phase_prep(const Frame& F0, KArgs a0, int layer) {
    Frame F = F0; F.tid = fresh_tid(); F.lane = F.tid & 63; F.wave = __builtin_amdgcn_readfirstlane(F.tid >> 6); const KArgs a = fresh_args(a0); unsigned char* const ws_ = a->ws; F.ctl = (unsigned*)(ws_ + WS_CTL);
    bf16_t* PROJ = (bf16_t*)(ws_ + WS_PROJ); bf16_t* VT = (bf16_t*)(ws_ + WS_VT); float* KMEAN = (float*)(ws_ + WS_KMEAN);
    constexpr int N_NORM = CHB * 8 * 8, N_TR = CHB * 8 * 24, NITEMS = N_NORM + N_TR;
    for (int it = F.bid; it < NITEMS; it += F.G) {
        if (it < N_NORM) {
            const int cg = it & 7, blk = (it >> 3) & 7, b = it >> 6;
            const int colbase = (cg < 4 ? 0 : 3072) + ((cg >> 1) & 1) * 1024 + (cg & 1) * 512;
            const bool isq = ((cg >> 1) & 1) == 0; const bool iska = (cg == 2 || cg == 3);
            const float* gain = (cg < 2 ? a->moba_q_gain : cg < 4 ? a->moba_k_gain : cg < 6 ? a->diff_q_gain : a->diff_k_gain) + layer * HD;
            const int c8 = (F.lane & 15) * 8;
            f32x4 g0 = *(const f32x4*)(gain + c8), g1 = *(const f32x4*)(gain + c8 + 4);
            if (isq) { g0 = g0 * QSCALE2; g1 = g1 * QSCALE2; }
            float ka[8];
#pragma unroll
            for (int j = 0; j < 8; ++j) ka[j] = 0.f;
            const size_t row0 = (size_t)b * SEQ + blk * 256 + F.wave * 32;
            for (int t = 0; t < 32; ++t) {
                bf16_t* p = PROJ + (row0 + t) * INC + colbase + F.lane * 8;
                const u32x4 w = *(const u32x4*)p;
                float x[8] = {bflo(w.x), bfhi(w.x), bflo(w.y), bfhi(w.y), bflo(w.z), bfhi(w.z), bflo(w.w), bfhi(w.w)};
                float ss = 0.f;
#pragma unroll
                for (int j = 0; j < 8; ++j) ss += x[j] * x[j];
                ss += __shfl_xor(ss, 1); ss += __shfl_xor(ss, 2); ss += __shfl_xor(ss, 4); ss += __shfl_xor(ss, 8);
                const float rstd = 1.0f / sqrtf(ss * (1.f / HD) + RMS_EPS);
                float y[8];
                y[0] = x[0] * rstd * g0.x; y[1] = x[1] * rstd * g0.y; y[2] = x[2] * rstd * g0.z; y[3] = x[3] * rstd * g0.w;
                y[4] = x[4] * rstd * g1.x; y[5] = x[5] * rstd * g1.y; y[6] = x[6] * rstd * g1.z; y[7] = x[7] * rstd * g1.w;
#pragma unroll
                for (int j = 0; j < 8; ++j) ka[j] += y[j];
                u32x4 o; o.x = pk2(y[0], y[1]); o.y = pk2(y[2], y[3]); o.z = pk2(y[4], y[5]); o.w = pk2(y[6], y[7]);
                *(u32x4*)p = o;
            }
            if (iska) {
                LAS float* red = (LAS float*)F.lds;
#pragma unroll
                for (int j = 0; j < 8; ++j) red[F.wave * 512 + F.lane * 8 + j] = ka[j];
                __syncthreads();
                { const int c = F.tid; float s = 0.f;
#pragma unroll
                  for (int w = 0; w < 8; ++w) s += red[w * 512 + c];
                  const int head = (cg - 2) * 4 + (c >> 7), d = c & 127;
                  KMEAN[(((size_t)b * 8 + head) * 8 + blk) * HD + d] = s * (1.f / 256.f); }
                __syncthreads();
            }
        } else {
            const int r = it - N_NORM; const int cgp = r % 24, blk = (r / 24) & 7, b = r / (24 * 8);
            const int m = cgp >> 3, cin = (cgp & 7) * 128 + (F.wave >> 2) * 64;
            const int tok0 = blk * 256 + (F.wave & 3) * 64;
            LAS unsigned short* tl = (LAS unsigned short*)(F.lds + F.wave * 16384);
            const bf16_t* src = PROJ + ((size_t)b * SEQ + tok0) * INC + m * 3072 + 2048 + cin;
            const int tr = F.lane >> 3, cc = F.lane & 7;
#pragma unroll
            for (int i = 0; i < 8; ++i) {
                const u32x4 w = *(const u32x4*)(src + (size_t)(8 * i + tr) * INC + cc * 8);
                const int tk = 8 * i + tr; LAS unsigned short* q = tl + (cc * 8) * 72 + tk;
                q[0 * 72] = (unsigned short)(w.x & 0xffff); q[1 * 72] = (unsigned short)(w.x >> 16); q[2 * 72] = (unsigned short)(w.y & 0xffff); q[3 * 72] = (unsigned short)(w.y >> 16);
                q[4 * 72] = (unsigned short)(w.z & 0xffff); q[5 * 72] = (unsigned short)(w.z >> 16); q[6 * 72] = (unsigned short)(w.w & 0xffff); q[7 * 72] = (unsigned short)(w.w >> 16);
            }
            LDS_WAIT(); asm volatile("" ::: "memory");
            bf16_t* dst = VT + (((size_t)b * 3 + m) * MIXW + cin) * SEQ + tok0;
#pragma unroll
            for (int i = 0; i < 8; ++i) { const int c = (F.lane >> 3) + 8 * i, q8 = F.lane & 7;
                const u32x4 w = *(const LAS u32x4*)(tl + c * 72 + q8 * 8);
                *(u32x4*)(dst + (size_t)c * SEQ + q8 * 8) = w; }
            LDS_WAIT(); asm volatile("" ::: "memory");
        }
    }
    __syncthreads();
}
#define MFMA32(a, b, c) __builtin_amdgcn_mfma_f32_32x32x16_bf16((a), (b), (c), 0, 0, 0)
constexpr int KROW = 272, VROW = 136;
constexpr int AT_K0 = 0, AT_K1 = 64 * KROW, AT_V = 2 * 64 * KROW, AT_LX = AT_V + 256 * VROW, AT_KM = AT_LX + 1024, AT_WQ = AT_KM + 8 * 128 * 4, AT_SC = AT_WQ + 64, AT_END = AT_SC + 64;
static_assert(AT_END <= RING_BYTES, "attention LDS");

__device__ __forceinline__ float xhalf_sum(float x) { const auto rr = __builtin_amdgcn_permlane32_swap(__float_as_uint(x), __float_as_uint(x), false, false); return __uint_as_float(rr[0]) + __uint_as_float(rr[1]); }
__device__ __forceinline__ float xhalf_partner(float x, int hh) { const auto rr = __builtin_amdgcn_permlane32_swap(__float_as_uint(x), __float_as_uint(x), false, false); return __uint_as_float(hh ? rr[0] : rr[1]); }
__device__ __forceinline__ bf16x8 pack8(const f32x16& p, int s) {
    u32x4 w;
    if (s == 0) { w.x = pk2(p[0], p[1]); w.y = pk2(p[2], p[3]); w.z = pk2(p[4], p[5]); w.w = pk2(p[6], p[7]); }
    else        { w.x = pk2(p[8], p[9]); w.y = pk2(p[10], p[11]); w.z = pk2(p[12], p[13]); w.w = pk2(p[14], p[15]); }
    return __builtin_bit_cast(bf16x8, w);
}
__device__ __forceinline__ f32x16 zero16() { f32x16 z;
#pragma unroll
    for (int i = 0; i < 16; ++i) z[i] = 0.f;
    return z; }
template <bool LIM = false>
__device__ __forceinline__ f32x16 qk_block(const LAS unsigned char* Kl, int kb, int r, int hh, const bf16x8 (&qf)[8]) {
    f32x16 S = zero16();
#pragma unroll
    for (int s = 0; s < 8; ++s) { const bf16x8 kf = *(const LAS bf16x8*)(Kl + (32 * kb + r) * KROW + (16 * s + 8 * hh) * 2); S = MFMA32(kf, qf[s], S);
        if (LIM && s == 3) __builtin_amdgcn_sched_barrier(0); }
    return S;
}
template <bool LIM = false>
__device__ __forceinline__ void pv_block(const LAS unsigned char* Vl, int drow0, int kb, int r, int hh, const f32x16& p, f32x16 (&O)[4]) {
    const bf16x8 pk0 = pack8(p, 0), pk1 = pack8(p, 1);
#pragma unroll
    for (int db = 0; db < 4; ++db) {
#pragma unroll
        for (int s2 = 0; s2 < 2; ++s2) {
            const LAS unsigned char* ap = Vl + (drow0 + 32 * db + r) * VROW + (32 * kb + 16 * s2 + 4 * hh) * 2;
            const s16x4 lo = *(const LAS s16x4*)ap, hi = *(const LAS s16x4*)(ap + 16);
            const bf16x8 vf = __builtin_shufflevector(lo, hi, 0, 1, 2, 3, 4, 5, 6, 7);
            O[db] = MFMA32(vf, s2 ? pk1 : pk0, O[db]);
        }
        if (LIM && (db & 1)) __builtin_amdgcn_sched_barrier(0);
    }
}
__device__ __forceinline__ u32x4 ldg16(const char* base, unsigned off) { return *(const u32x4*)(base + off); }
__device__ __forceinline__ void k_fetch(u32x4 (&pre)[2], const bf16_t* Kp, int k0, int tid) {
    const char* base = (const char*)(Kp + (size_t)k0 * INC);
#pragma unroll
    for (int i = 0; i < 2; ++i) { const unsigned c = (unsigned)tid + 512u * i, key = c >> 4, part = c & 15u; pre[i] = ldg16(base, key * (unsigned)(INC * 2) + part * 16u); }
}
__device__ __forceinline__ void k_stash(const u32x4 (&pre)[2], LAS unsigned char* Kl, int tid) {
#pragma unroll
    for (int i = 0; i < 2; ++i) { const int c = tid + 512 * i, key = c >> 4, part = c & 15; *(LAS u32x4*)(Kl + key * KROW + part * 16) = pre[i]; }
}
template <int NCHK> __device__ __forceinline__ void v_fetch(u32x4 (&pre)[NCHK], const bf16_t* Vtp, int k0, int tid) {
    const char* base = (const char*)(Vtp + k0);
#pragma unroll
    for (int i = 0; i < NCHK; ++i) { const unsigned c = (unsigned)tid + 512u * i, d = c >> 3, part = c & 7u; pre[i] = ldg16(base, d * (unsigned)(SEQ * 2) + part * 16u); }
}
template <int NCHK> __device__ __forceinline__ void v_stash(const u32x4 (&pre)[NCHK], LAS unsigned char* Vl, int tid) {
#pragma unroll
    for (int i = 0; i < NCHK; ++i) { const int c = tid + 512 * i, d = c >> 3, part = c & 7; LAS u32x2* q = (LAS u32x2*)(Vl + d * VROW + part * 16);
        q[0] = (u32x2){pre[i].x, pre[i].y}; q[1] = (u32x2){pre[i].z, pre[i].w}; }
}
__device__ __forceinline__ void store_ot(const f32x16 (&O)[4], bf16_t* orow  , int hh, float sc) {
#pragma unroll
    for (int db = 0; db < 4; ++db)
#pragma unroll
        for (int g = 0; g < 4; ++g) { u32x2 o; o.x = pk2(O[db][4 * g] * sc, O[db][4 * g + 1] * sc); o.y = pk2(O[db][4 * g + 2] * sc, O[db][4 * g + 3] * sc);
            *(u32x2*)(orow + 32 * db + 8 * g + 4 * hh) = o; }
}

template <int MODE>
__device__ __forceinline__ void attn_unit_ac(LAS unsigned char* lds, const bf16_t* Qp, const bf16_t* Kp, const bf16_t* Vtp, bf16_t* Op, int q0, float slope2, float m2, const float* kmean_bh) {
    const int tid = fresh_tid(), w = __builtin_amdgcn_readfirstlane(tid >> 6), lane = tid & 63, r = lane & 31, hh = lane >> 5;
    const int wq0 = q0 + 32 * w, tq = wq0 + r;
    LAS unsigned char* Kl = lds + AT_K0; LAS unsigned char* Vl = lds + AT_V;
    bf16x8 qf[8];
#pragma unroll
    for (int s = 0; s < 8; ++s) qf[s] = *(const bf16x8*)(Qp + (size_t)tq * INC + 16 * s + 8 * hh);
    const int own = q0 >> 8;
    unsigned selmask = 0u;
    if (MODE == 0) {
        LAS float* KM = (LAS float*)(lds + AT_KM);
        for (int idx = tid; idx < own * HD; idx += NTHR) KM[idx] = kmean_bh[idx];
        __syncthreads();
        float gsc[7];
#pragma unroll
        for (int n = 0; n < 7; ++n) {
            float acc = 0.f;
            if (n < own) {
#pragma unroll
                for (int s = 0; s < 8; ++s) { const f32x4 k0v = *(const LAS f32x4*)(KM + n * HD + 16 * s + 8 * hh), k1v = *(const LAS f32x4*)(KM + n * HD + 16 * s + 8 * hh + 4);
                    acc += bf2f((unsigned short)qf[s][0]) * k0v.x + bf2f((unsigned short)qf[s][1]) * k0v.y + bf2f((unsigned short)qf[s][2]) * k0v.z + bf2f((unsigned short)qf[s][3]) * k0v.w
                         + bf2f((unsigned short)qf[s][4]) * k1v.x + bf2f((unsigned short)qf[s][5]) * k1v.y + bf2f((unsigned short)qf[s][6]) * k1v.z + bf2f((unsigned short)qf[s][7]) * k1v.w; }
            }
            gsc[n] = xhalf_sum(acc);
        }
        if (own <= 3) selmask = (1u << own) - 1u;
        else {
#pragma unroll
            for (int pick = 0; pick < 3; ++pick) { float best = -__builtin_inff(); int bi = 0;
#pragma unroll
                for (int n = 0; n < 7; ++n) { const bool ok = (n < own) && !((selmask >> n) & 1u) && (gsc[n] > best); best = ok ? gsc[n] : best; bi = ok ? n : bi; }
                selmask |= 1u << bi; }
        }
    }
    f32x16 O[4];
#pragma unroll
    for (int db = 0; db < 4; ++db) O[db] = zero16();
    float lsum = 0.f, prun = 1.f;
    const int kt_hi = (q0 >> 6) + 3;
    u32x4 pk_[2], pv_[2];
    k_fetch(pk_, Kp, kt_hi * 64, tid); v_fetch<2>(pv_, Vtp, kt_hi * 64, tid);
    for (int kt = kt_hi; kt >= 0; --kt) {
        k_stash(pk_, Kl, tid); v_stash<2>(pv_, Vl, tid);
        __syncthreads();
        if (kt > 0) { k_fetch(pk_, Kp, (kt - 1) * 64, tid); v_fetch<2>(pv_, Vtp, (kt - 1) * 64, tid); }
        const int k0 = kt * 64, kb256 = kt >> 2;
        const bool diag = (kb256 == own);
        bool active = (MODE == 0) ? (k0 <= wq0 + 31) : (k0 < wq0 + 31);
        const bool sel = ((selmask >> kb256) & 1u) != 0u;
        if (MODE == 0 && !diag) active = __any(sel ? 1 : 0) != 0;
        if (active) {
#pragma unroll
            for (int kbi = 0; kbi < 2; ++kbi) {
                const int kb = 1 - kbi;
                f32x16 S = qk_block(Kl, kb, r, hh, qf);
                const int kbase = k0 + 32 * kb + 4 * hh - tq;
                if (MODE == 0) {
                    const float base = slope2 * (float)kbase - m2;
#pragma unroll
                    for (int i = 0; i < 16; ++i) { const int cI = (i & 3) + 8 * (i >> 2);
                        const float e = fast_exp2(S[i] + (base + slope2 * (float)cI));
                        const bool vis = diag ? (kbase + cI <= 0) : sel;
                        S[i] = vis ? e : 0.f; lsum += S[i]; }
                } else {
                    float sg[16], kp[16];
#pragma unroll
                    for (int i = 0; i < 16; ++i) { const int cI = (i & 3) + 8 * (i >> 2);
                        const float z = S[i] * QSCALE2;
                        const float en = fast_exp2(-fabsf(z)), rc = fast_rcp(1.0f + en), sm = en * rc;
                        const bool pos = z >= 0.f, vis = (kbase + cI < 0);
                        sg[i] = vis ? (pos ? rc : sm) : 0.f; kp[i] = vis ? (pos ? sm : rc) : 1.f; }
                    float G[4], Gp[4];
#pragma unroll
                    for (int g = 0; g < 4; ++g) { G[g] = (kp[4 * g] * kp[4 * g + 1]) * (kp[4 * g + 2] * kp[4 * g + 3]); Gp[g] = xhalf_partner(G[g], hh); }
                    float run = prun;
#pragma unroll
                    for (int g = 3; g >= 0; --g) {
                        float t = (hh == 0) ? run * Gp[g] : run;
                        S[4 * g + 3] = sg[4 * g + 3] * t; t *= kp[4 * g + 3];
                        S[4 * g + 2] = sg[4 * g + 2] * t; t *= kp[4 * g + 2];
                        S[4 * g + 1] = sg[4 * g + 1] * t; t *= kp[4 * g + 1];
                        S[4 * g + 0] = sg[4 * g + 0] * t;
                        run = run * (G[g] * Gp[g]);
                    }
                    prun = run;
                }
                pv_block(Vl, 0, kb, r, hh, S, O);
            }
        }
        __syncthreads();
    }
    float sc = 1.f;
    if (MODE == 0) { const float lt = xhalf_sum(lsum); sc = 1.0f / lt; }
    store_ot(O, Op + (size_t)tq * (3 * MIXW), hh, sc);
}

__device__ __forceinline__ void attn_unit_b(LAS unsigned char* lds, const bf16_t* Qp, const bf16_t* Kp, const bf16_t* Vtp, bf16_t* Op, int q0, float slope2, float m2, float lam, float outscale, const float* hgain) {
    const int tid = fresh_tid(), w = __builtin_amdgcn_readfirstlane(tid >> 6), lane = tid & 63, r = lane & 31, hh = lane >> 5;
    const int qsub = w & 3, dh = w >> 2;
    const int wq0 = q0 + 32 * qsub, tq = wq0 + r;
    LAS unsigned char* Kl0 = lds + AT_K0; LAS unsigned char* Kl1 = lds + AT_K1; LAS unsigned char* Vl = lds + AT_V; LAS float* LX = (LAS float*)(lds + AT_LX);
    bf16x8 qf0[8], qf1[8];
#pragma unroll
    for (int s = 0; s < 8; ++s) { qf0[s] = *(const bf16x8*)(Qp + (size_t)tq * INC + 16 * s + 8 * hh); qf1[s] = *(const bf16x8*)(Qp + (size_t)tq * INC + HD + 16 * s + 8 * hh); }
    const int kt_hi = (q0 >> 6) + 1;
    float lsum = 0.f;
    {
        u32x4 pa[2], pb[2];
        k_fetch(pa, Kp, kt_hi * 64, tid); k_fetch(pb, Kp + HD, kt_hi * 64, tid);
        for (int kt = kt_hi; kt >= 0; --kt) {
            k_stash(pa, Kl0, tid); k_stash(pb, Kl1, tid);
            __syncthreads();
            if (kt > 0) { k_fetch(pa, Kp, (kt - 1) * 64, tid); k_fetch(pb, Kp + HD, (kt - 1) * 64, tid); }
            const int k0 = kt * 64;
            if (k0 <= wq0 + 31) {
#pragma unroll
                for (int kb = 0; kb < 2; ++kb) {
                    f32x16 S;
                    if (dh == 0) S = qk_block(Kl0, kb, r, hh, qf0); else S = qk_block(Kl1, kb, r, hh, qf1);
                    const int kbase = k0 + 32 * kb + 4 * hh - tq; const float base = slope2 * (float)kbase - m2;
#pragma unroll
                    for (int i = 0; i < 16; ++i) { const int cI = (i & 3) + 8 * (i >> 2); const float e = fast_exp2(S[i] + (base + slope2 * (float)cI)); lsum += (kbase + cI <= 0) ? e : 0.f; }
                }
            }
            __syncthreads();
        }
    }
    { const float lt = xhalf_sum(lsum); if (hh == 0) LX[dh * 128 + 32 * qsub + r] = lt; }
    __syncthreads();
    const float c0 = 1.0f / LX[32 * qsub + r], c1 = lam / LX[128 + 32 * qsub + r];
    f32x16 O[4];
#pragma unroll
    for (int db = 0; db < 4; ++db) O[db] = zero16();
    {
        u32x4 pa[2], pb[2], pv_[4];
        k_fetch(pa, Kp, kt_hi * 64, tid); k_fetch(pb, Kp + HD, kt_hi * 64, tid); v_fetch<4>(pv_, Vtp, kt_hi * 64, tid);
        for (int kt = kt_hi; kt >= 0; --kt) {
            k_stash(pa, Kl0, tid); k_stash(pb, Kl1, tid); v_stash<4>(pv_, Vl, tid);
            __syncthreads();
            if (kt > 0) { k_fetch(pa, Kp, (kt - 1) * 64, tid); k_fetch(pb, Kp + HD, (kt - 1) * 64, tid); }
            const int k0 = kt * 64;
            if (k0 <= wq0 + 31) {
#pragma unroll 1
                for (int kb = 0; kb < 2; ++kb) {
                    const int kbase = k0 + 32 * kb + 4 * hh - tq; const float base = slope2 * (float)kbase - m2;
                    f32x16 S0 = qk_block(Kl0, kb, r, hh, qf0);
                    const f32x16 S1 = qk_block(Kl1, kb, r, hh, qf1);
#pragma unroll
                    for (int i = 0; i < 16; ++i) { const int cI = (i & 3) + 8 * (i >> 2); const float bi = base + slope2 * (float)cI;
                        const float e0 = fast_exp2(S0[i] + bi) * c0, e1 = fast_exp2(S1[i] + bi) * c1; S0[i] = (kbase + cI <= 0) ? (e0 - e1) : 0.f; }
                    pv_block(Vl, 128 * dh, kb, r, hh, S0, O);
                }
            }
            if (kt > 0) v_fetch<4>(pv_, Vtp, (kt - 1) * 64, tid);
            __syncthreads();
        }
    }
    float ss = 0.f;
#pragma unroll
    for (int db = 0; db < 4; ++db)
#pragma unroll
        for (int i = 0; i < 16; ++i) ss += O[db][i] * O[db][i];
    ss = xhalf_sum(ss);
    int tz = threadIdx.x; asm volatile("" : "+v"(tz));
    const int lane2 = tz & 63, r2 = lane2 & 31, hh2 = lane2 >> 5, w2 = tz >> 6, qs2 = w2 & 3, dh2 = w2 >> 2;
    if (hh2 == 0) LX[dh2 * 128 + 32 * qs2 + r2] = ss;
    __syncthreads();
    const float tot = LX[32 * qs2 + r2] + LX[128 + 32 * qs2 + r2];
    const float rstd = outscale / sqrtf(tot * (1.f / 256.f) + RMS_EPS);
    bf16_t* orow = Op + (size_t)(q0 + 32 * qs2 + r2) * (3 * MIXW) + 128 * dh2;
#pragma unroll
    for (int db = 0; db < 4; ++db)
#pragma unroll
        for (int g = 0; g < 4; ++g) { const int d = 32 * db + 8 * g + 4 * hh2; const f32x4 hg = *(const f32x4*)(hgain + 128 * dh2 + d);
            u32x2 o; o.x = pk2(O[db][4 * g] * rstd * hg.x, O[db][4 * g + 1] * rstd * hg.y); o.y = pk2(O[db][4 * g + 2] * rstd * hg.z, O[db][4 * g + 3] * rstd * hg.w);
            *(u32x2*)(orow + d) = o; }
    __syncthreads();
}

__device__ __forceinline__ int wq_pop(unsigned* ctr, LAS unsigned char* lds) {
    volatile LAS unsigned* slot = (volatile LAS unsigned*)(lds + AT_WQ);
    __syncthreads();
    if (threadIdx.x == 0) slot[0] = __hip_atomic_fetch_add(ctr, 1u, __ATOMIC_RELAXED, __HIP_MEMORY_SCOPE_AGENT);
    __syncthreads();
    return (int)__builtin_amdgcn_readfirstlane(slot[0]);
}
__device__ __forceinline__ void phase_attn(const Frame& F0, KArgs a0, int layer_in, int chunk) {
    int layer = layer_in; asm volatile("" : "+s"(layer));
    Frame F = F0; F.tid = fresh_tid(); F.lane = F.tid & 63; F.wave = __builtin_amdgcn_readfirstlane(F.tid >> 6); const KArgs a = fresh_args(a0); unsigned char* const ws_ = a->ws; F.ctl = (unsigned*)(ws_ + WS_CTL);
    const bf16_t* PROJ = (const bf16_t*)(ws_ + WS_PROJ); const bf16_t* VT = (const bf16_t*)(ws_ + WS_VT); bf16_t* BR = (bf16_t*)(ws_ + WS_BR); const float* KMEAN = (const float*)(ws_ + WS_KMEAN);
    unsigned* wq = F.ctl + CW_WQ + ((layer * NCH + chunk) * 3) * 64;
    float gqa = fmaxf(fabsf(a->moba_q_gain[layer * HD + F.lane]), fabsf(a->moba_q_gain[layer * HD + 64 + F.lane]));
    float gka = fmaxf(fabsf(a->moba_k_gain[layer * HD + F.lane]), fabsf(a->moba_k_gain[layer * HD + 64 + F.lane]));
    float gqb = fmaxf(fabsf(a->diff_q_gain[layer * HD + F.lane]), fabsf(a->diff_q_gain[layer * HD + 64 + F.lane]));
    float gkb = fmaxf(fabsf(a->diff_k_gain[layer * HD + F.lane]), fabsf(a->diff_k_gain[layer * HD + 64 + F.lane]));
    {
        const float m2a_ = 128.f * QSCALE2 * wave_max(gqa) * wave_max(gka), m2b_ = 128.f * QSCALE2 * wave_max(gqb) * wave_max(gkb);
        const float s1 = wave_sum(a->lq1[layer * HD + F.lane] * a->lk1[layer * HD + F.lane] + a->lq1[layer * HD + 64 + F.lane] * a->lk1[layer * HD + 64 + F.lane]);
        const float s2 = wave_sum(a->lq2[layer * HD + F.lane] * a->lk2[layer * HD + F.lane] + a->lq2[layer * HD + 64 + F.lane] * a->lk2[layer * HD + 64 + F.lane]);
        const float lam_init = layer == 0 ? 0.2f : 0.35550906759096926f;
        static_assert(DEPTH == 2, "lam_init table");
        volatile LAS float* sc = (volatile LAS float*)(F.lds + AT_SC);
        __syncthreads();
        if (F.tid == 0) { sc[0] = m2a_; sc[1] = m2b_; sc[2] = expf(s1) - expf(s2) + lam_init; sc[3] = 1.0f - lam_init; }
        __syncthreads();
    }
    volatile LAS float* sc = (volatile LAS float*)(F.lds + AT_SC);
    for (;;) {
        const int u = wq_pop(wq + 0 * 64, F.lds); if (u >= 16 * CHB * 4) break;
        const int qb = 15 - (u >> 5), b = (u & 31) >> 2, hb = u & 3;
        const float slope2 = exp2f(-2.0f * (float)(hb + 1)) * 1.4426950408889634f;
        const bf16_t* base = PROJ + (size_t)b * SEQ * INC;
        attn_unit_b(F.lds, base + 3072 + hb * 256, base + 4096 + hb * 256, VT + (((size_t)b * 3 + 1) * MIXW + hb * 256) * SEQ, BR + (size_t)b * SEQ * (3 * MIXW) + MIXW + hb * 256,
                    qb * 128, slope2, uniformf(sc[1]), uniformf(sc[2]), uniformf(sc[3]), a->diff_head_gain + layer * 256);
    }
    for (;;) {
        const int u = wq_pop(wq + 1 * 64, F.lds); if (u >= 8 * CHB * 8) break;
        const int qb = 7 - (u >> 6), b = (u & 63) >> 3, h = u & 7;
        const float slope2 = exp2f(-(float)(h + 1)) * 1.4426950408889634f;
        const bf16_t* base = PROJ + (size_t)b * SEQ * INC;
        attn_unit_ac<0>(F.lds, base + h * HD, base + 1024 + h * HD, VT + (((size_t)b * 3 + 0) * MIXW + h * HD) * SEQ, BR + (size_t)b * SEQ * (3 * MIXW) + h * HD,
                        qb * 256, slope2, uniformf(sc[0]), KMEAN + ((size_t)b * 8 + h) * 8 * HD);
    }
    for (;;) {
        const int u = wq_pop(wq + 2 * 64, F.lds); if (u >= 8 * CHB * 8) break;
        const int qb = 7 - (u >> 6), b = (u & 63) >> 3, h = u & 7;
        const bf16_t* base = PROJ + (size_t)b * SEQ * INC;
        attn_unit_ac<2>(F.lds, base + 6144 + h * HD, base + 7168 + h * HD, VT + (((size_t)b * 3 + 2) * MIXW + h * HD) * SEQ, BR + (size_t)b * SEQ * (3 * MIXW) + 2 * MIXW + h * HD,
                        qb * 256, 0.f, 0.f, nullptr);
    }
}
__device__ __forceinline__ void phase_router(const Frame& F0, KArgs a0, int layer) {
    Frame F = F0; F.tid = fresh_tid(); F.lane = F.tid & 63; F.wave = __builtin_amdgcn_readfirstlane(F.tid >> 6); const KArgs a = fresh_args(a0); unsigned char* const ws_ = a->ws; F.ctl = (unsigned*)(ws_ + WS_CTL);
    bf16_t* H = (bf16_t*)(ws_ + WS_H);
    int* tok_e = (int*)(ws_ + WS_ROUT + RO_E); float* tok_w = (float*)(ws_ + WS_ROUT + RO_W);
    const float* gain = a->ffn_norm_g + layer * D; const float* wrg = a->w_rg + (size_t)layer * D * 4; const float* wre = a->w_re + (size_t)layer * D * NEXP;
    const int gw = F.bid * NWAVES + F.wave, NGW = F.G * NWAVES;
    LAS f32x4* hl = (LAS f32x4*)(F.lds + F.wave * 16384);
    for (int p = gw; p < NTOK / 2; p += NGW) {
        {
            f32x4 v0[8], v1[8];
            { const f32x4* x0 = (const f32x4*)(a->out + (size_t)(2 * p) * D) + F.lane; const f32x4* x1 = x0 + D / 4;
#pragma unroll
              for (int j = 0; j < 8; ++j) { v0[j] = x0[64 * j]; v1[j] = x1[64 * j]; } }
            float s0 = 0.f, s1 = 0.f;
#pragma unroll
            for (int j = 0; j < 8; ++j) { s0 += (v0[j].x * v0[j].x + v0[j].y * v0[j].y) + (v0[j].z * v0[j].z + v0[j].w * v0[j].w); s1 += (v1[j].x * v1[j].x + v1[j].y * v1[j].y) + (v1[j].z * v1[j].z + v1[j].w * v1[j].w); }
            const float r0 = 1.0f / sqrtf(wave_sum(s0) * (1.f / D) + RMS_EPS), r1 = 1.0f / sqrtf(wave_sum(s1) * (1.f / D) + RMS_EPS);
            u32x2* o0 = (u32x2*)(H + (size_t)(2 * p) * D) + F.lane; u32x2* o1 = o0 + D / 4;
#pragma unroll
            for (int j = 0; j < 8; ++j) { const f32x4 g = *((const f32x4*)gain + F.lane + 64 * j);
                v0[j] = v0[j] * r0 * g; v1[j] = v1[j] * r1 * g;
                hl[j * 64 + F.lane] = v0[j]; hl[512 + j * 64 + F.lane] = v1[j];
                u32x2 q; q.x = pk2(v0[j].x, v0[j].y); q.y = pk2(v0[j].z, v0[j].w); o0[64 * j] = q;
                q.x = pk2(v1[j].x, v1[j].y); q.y = pk2(v1[j].z, v1[j].w); o1[64 * j] = q; }
        }
        LDS_WAIT();
        float g0[4] = {0.f, 0.f, 0.f, 0.f}, g1[4] = {0.f, 0.f, 0.f, 0.f};
#pragma unroll 1
        for (int j = 0; j < 8; ++j) {
            const f32x4 h0v = hl[j * 64 + F.lane], h1v = hl[512 + j * 64 + F.lane];
            const float* wp = wrg + (size_t)(4 * F.lane + 256 * j) * 4;
#pragma unroll
            for (int c = 0; c < 4; ++c) {
                const float h0 = h0v[c], h1 = h1v[c];
                const f32x4 wg = *(const f32x4*)(wp + c * 4);
                g0[0] += h0 * wg.x; g0[1] += h0 * wg.y; g0[2] += h0 * wg.z; g0[3] += h0 * wg.w;
                g1[0] += h1 * wg.x; g1[1] += h1 * wg.y; g1[2] += h1 * wg.z; g1[3] += h1 * wg.w;
            }
        }
#pragma unroll
        for (int i = 0; i < 4; ++i) { g0[i] = wave_sum(g0[i]); g1[i] = wave_sum(g1[i]); }
        int gi0 = 0, gi1 = 0; float gm0 = g0[0], gm1 = g1[0];
#pragma unroll
        for (int i = 1; i < 4; ++i) { if (g0[i] > gm0) { gm0 = g0[i]; gi0 = i; } if (g1[i] > gm1) { gm1 = g1[i]; gi1 = i; } }
        gi0 = __builtin_amdgcn_readfirstlane(gi0); gi1 = __builtin_amdgcn_readfirstlane(gi1);
        float gz0 = 0.f, gz1 = 0.f;
#pragma unroll
        for (int i = 0; i < 4; ++i) { gz0 += expf(g0[i] - gm0); gz1 += expf(g1[i] - gm1); }
        float e0[8], e1[8];
#pragma unroll
        for (int q = 0; q < 8; ++q) { e0[q] = 0.f; e1[q] = 0.f; }
        const float* wre0 = wre + gi0 * 8; const float* wre1 = wre + gi1 * 8;
#pragma unroll 1
        for (int j = 0; j < 8; ++j) {
            const f32x4 h0v = hl[j * 64 + F.lane], h1v = hl[512 + j * 64 + F.lane];
            const size_t ko = (size_t)(4 * F.lane + 256 * j) * NEXP;
#pragma unroll
            for (int c = 0; c < 4; ++c) {
                const float h0 = h0v[c], h1 = h1v[c];
                const f32x4 wa = *(const f32x4*)(wre0 + ko + c * NEXP), wb = *(const f32x4*)(wre0 + ko + c * NEXP + 4);
                const f32x4 wc = *(const f32x4*)(wre1 + ko + c * NEXP), wd = *(const f32x4*)(wre1 + ko + c * NEXP + 4);
                e0[0] += h0 * wa.x; e0[1] += h0 * wa.y; e0[2] += h0 * wa.z; e0[3] += h0 * wa.w; e0[4] += h0 * wb.x; e0[5] += h0 * wb.y; e0[6] += h0 * wb.z; e0[7] += h0 * wb.w;
                e1[0] += h1 * wc.x; e1[1] += h1 * wc.y; e1[2] += h1 * wc.z; e1[3] += h1 * wc.w; e1[4] += h1 * wd.x; e1[5] += h1 * wd.y; e1[6] += h1 * wd.z; e1[7] += h1 * wd.w;
            }
        }
#pragma unroll
        for (int q = 0; q < 8; ++q) { e0[q] = wave_sum(e0[q]); e1[q] = wave_sum(e1[q]); }
#pragma unroll
        for (int tt = 0; tt < 2; ++tt) {
            float es[8];
#pragma unroll
            for (int q = 0; q < 8; ++q) es[q] = tt ? e1[q] : e0[q];
            const int gi = tt ? gi1 : gi0; const float gtop = 1.0f / (tt ? gz1 : gz0);
            int i0 = 0; float m0 = es[0];
#pragma unroll
            for (int q = 1; q < 8; ++q) { if (es[q] > m0) { m0 = es[q]; i0 = q; } }
            int i1 = -1; float m1 = -__builtin_inff();
#pragma unroll
            for (int q = 0; q < 8; ++q) { if (q != i0 && es[q] > m1) { m1 = es[q]; i1 = q; } }
            const float p1 = expf(m1 - m0);
            const float w0 = gtop / (1.0f + p1), w1 = gtop * p1 / (1.0f + p1);
            if (F.lane == 0) { const int m = 2 * p + tt; tok_e[2 * m] = gi * 8 + i0; tok_e[2 * m + 1] = gi * 8 + i1; tok_w[2 * m] = w0; tok_w[2 * m + 1] = w1; }
        }
    }
}
__device__ __forceinline__ void phase_bin(const Frame& F0, KArgs a0, int layer) {
    Frame F = F0; F.tid = fresh_tid(); F.lane = F.tid & 63; F.wave = __builtin_amdgcn_readfirstlane(F.tid >> 6); const KArgs a = fresh_args(a0); unsigned char* const ws_ = a->ws; F.ctl = (unsigned*)(ws_ + WS_CTL);
    const int* tok_e = (const int*)(ws_ + WS_ROUT + RO_E); int* a_pos = (int*)(ws_ + WS_ROUT + RO_POS);
    unsigned* cnt = F.ctl + CW_CNT + layer * NEXP * 64;
    LAS unsigned* hist = (LAS unsigned*)F.lds; LAS unsigned* basev = hist + 32;
    for (int base = F.bid * 256; base < NASSIGN; base += F.G * 256) {
        if (F.tid < 32) hist[F.tid] = 0u;
        __syncthreads();
        int e = 0; unsigned rank = 0u;
        if (F.tid < 256) { e = tok_e[base + F.tid]; rank = __hip_atomic_fetch_add(hist + e, 1u, __ATOMIC_RELAXED, __HIP_MEMORY_SCOPE_WORKGROUP); }
        __syncthreads();
        if (F.tid < 32) { const unsigned h = hist[F.tid]; basev[F.tid] = h ? __hip_atomic_fetch_add(cnt + F.tid * 64, h, __ATOMIC_RELAXED, __HIP_MEMORY_SCOPE_AGENT) : 0u; }
        __syncthreads();
        if (F.tid < 256) a_pos[base + F.tid] = (int)(basev[e] + rank);
        __syncthreads();
    }
}
__device__ __forceinline__ void phase_scatter(const Frame& F0, KArgs a0, int layer) {
    Frame F = F0; F.tid = fresh_tid(); F.lane = F.tid & 63; F.wave = __builtin_amdgcn_readfirstlane(F.tid >> 6); const KArgs a = fresh_args(a0); unsigned char* const ws_ = a->ws; F.ctl = (unsigned*)(ws_ + WS_CTL);
    const int* tok_e = (const int*)(ws_ + WS_ROUT + RO_E); const int* a_pos = (const int*)(ws_ + WS_ROUT + RO_POS); int* a_slot = (int*)(ws_ + WS_ROUT + RO_SLOT);
    int* tile_expert = (int*)(ws_ + WS_ROUT + RO_TILE);
    const bf16_t* H = (const bf16_t*)(ws_ + WS_H); bf16_t* XS = (bf16_t*)(ws_ + WS_XS);
    unsigned* cnt = F.ctl + CW_CNT + layer * NEXP * 64;
    LAS int* pstart = (LAS int*)F.lds; LAS int* pend = pstart + 32;
    if (F.tid == 0) { int run = 0;
        for (int e = 0; e < NEXP; ++e) { const int c = (int)__hip_atomic_load(cnt + e * 64, __ATOMIC_RELAXED, __HIP_MEMORY_SCOPE_AGENT); pstart[e] = run; run += ((c + 255) >> 8) << 8; pend[e] = run; } }
    __syncthreads();
    if (F.bid == 0 && F.tid <= MAXTILES) {
        const int ntiles = pend[NEXP - 1] >> 8;
        if (F.tid == MAXTILES) tile_expert[MAXTILES] = ntiles;
        else { int e = 0; for (int q = 0; q < NEXP; ++q) e += (pend[q] <= F.tid * 256) ? 1 : 0; tile_expert[F.tid] = e < NEXP ? e : NEXP - 1; }
    }
    for (int base = F.bid * 256; base < NASSIGN; base += F.G * 256) {
        for (int i = 0; i < 32; ++i) {
            const int as = base + F.wave * 32 + i;
            const int e = tok_e[as], slot = pstart[e] + a_pos[as];
            if (F.lane == 0) a_slot[as] = slot;
            const u32x4* src = (const u32x4*)(H + (size_t)(as >> 1) * D) + F.lane; u32x4* dst = (u32x4*)(XS + (size_t)slot * D) + F.lane;
#pragma unroll
            for (int j = 0; j < 4; ++j) dst[64 * j] = src[64 * j];
        }
    }
    __syncthreads();
}
__device__ __forceinline__ void phase_combine(const Frame& F0, KArgs a0, int layer) {
    Frame F = F0; F.tid = fresh_tid(); F.lane = F.tid & 63; F.wave = __builtin_amdgcn_readfirstlane(F.tid >> 6); const KArgs a = fresh_args(a0); unsigned char* const ws_ = a->ws; F.ctl = (unsigned*)(ws_ + WS_CTL);
    const int* a_slot = (const int*)(ws_ + WS_ROUT + RO_SLOT); const float* tok_w = (const float*)(ws_ + WS_ROUT + RO_W);
    const bf16_t* Y = (const bf16_t*)(ws_ + WS_Y); bf16_t* H = (bf16_t*)(ws_ + WS_H);
    const int gw = F.bid * NWAVES + F.wave, NGW = F.G * NWAVES;
    for (int m = gw; m < NTOK; m += NGW) {
        const int s0 = a_slot[2 * m], s1 = a_slot[2 * m + 1]; const float w0 = tok_w[2 * m], w1 = tok_w[2 * m + 1];
        f32x4* xr = (f32x4*)(a->out + (size_t)m * D) + F.lane;
        const u32x2* y0 = (const u32x2*)(Y + (size_t)s0 * D) + F.lane; const u32x2* y1 = (const u32x2*)(Y + (size_t)s1 * D) + F.lane;
        f32x4 v[8];
#pragma unroll
        for (int j = 0; j < 8; ++j) { const f32x4 x = xr[64 * j]; const u32x2 p = y0[64 * j], q = y1[64 * j];
            f32x4 c; c.x = w0 * bflo(p.x) + w1 * bflo(q.x); c.y = w0 * bfhi(p.x) + w1 * bfhi(q.x); c.z = w0 * bflo(p.y) + w1 * bflo(q.y); c.w = w0 * bfhi(p.y) + w1 * bfhi(q.y);
            v[j] = x + c; xr[64 * j] = v[j]; }
        if (layer + 1 < DEPTH) rms_row_to_bf16(v, a->attn_norm_g + (layer + 1) * D, H + (size_t)m * D, F.lane);
    }
}

constexpr int NSTEPS = 1 + DEPTH * (NCH * 5 + 6);
__global__ void __launch_bounds__(NTHR, 2) mega_fwd(Args a_unused) {
    const KArgs a = (KArgs)__builtin_amdgcn_kernarg_segment_ptr();
    extern __shared__ __attribute__((aligned(16))) unsigned char lds_raw[];
    Frame F;
    F.lds = (LAS unsigned char*)lds_raw; F.MISC = (volatile LAS unsigned*)(F.lds + MISC_OFF);
    F.tid = threadIdx.x; F.lane = F.tid & 63; F.wave = __builtin_amdgcn_readfirstlane(F.tid >> 6); F.G = gridDim.x; F.bid = blockIdx.x;
    F.ctl = (unsigned*)(a->ws + WS_CTL);
    for (int u = F.tid; u < 256; u += NTHR) ((LAS unsigned*)(F.lds + MISC_OFF))[u] = 0u;
    __syncthreads();
    const int lo = a->step_lo, hi = a->step_hi;
    XcdBarrier bar; bar.bar = F.ctl + CW_BAR; bar.x = 0; bar.st = nullptr;
    if (hi - lo > 1) bar = xcd_barrier_post(F.ctl + CW_BAR, F.MISC + 8);
    int step = 0;
#define PHASE_BEGIN if (step >= lo && step < hi) {
#define PHASE_END   if (step + 1 < hi) xcd_barrier(bar); } ++step;

    PHASE_BEGIN phase_norm0(F, a); phase_wconv(F, a, 0); __syncthreads(); PHASE_END

    for (int layer = 0; layer < DEPTH; ++layer) {
        for (int chunk = 0; chunk < NCH; ++chunk) {
            PHASE_BEGIN {
                unsigned char* const ws = fresh_args(a)->ws; bf16_t* H = (bf16_t*)(ws + WS_H); bf16_t* PROJ = (bf16_t*)(ws + WS_PROJ); const bf16_t* win_t = (const bf16_t*)(ws + WS_WIN);
                pg8::Gemm g{H + (size_t)chunk * CHT * D, win_t, D, D, D, 0}; pg8::StaticOrder S; S.init(CHT, INC, F.G, F.bid);
                pg8::EpiBf16Plain E{PROJ, INC};
                pg8::gemm_phase<pg8::EpiBf16Plain, pg8::StaticOrder, true>(F.lds, g, S, E);
            } PHASE_END
            PHASE_BEGIN phase_prep(F, a, layer); PHASE_END
            PHASE_BEGIN phase_attn(F, a, layer, chunk); PHASE_END
            PHASE_BEGIN {
                unsigned char* const ws = fresh_args(a)->ws; bf16_t* PROJ = (bf16_t*)(ws + WS_PROJ); bf16_t* BR = (bf16_t*)(ws + WS_BR); float* MIXF = (float*)(ws + WS_MIXF); bf16_t* MIXB = (bf16_t*)(ws + WS_MIXB); const bf16_t* wbr_t = (const bf16_t*)(ws + WS_WBR);
                for (int pass = 0; pass < 3; ++pass) {
                    pg8::Gemm g{BR + pass * MIXW, wbr_t + (size_t)pass * D * MIXW, 3 * MIXW, MIXW, MIXW, 0}; pg8::StaticOrder S; S.init(CHT, D, F.G, F.bid);
                    pg8::EpiGate E{PROJ + 9 * MIXW + pass * D, INC, a->gate_bias + (size_t)(layer * 3 + pass) * D, MIXF, MIXB, pass};
                    pg8::gemm_phase<pg8::EpiGate, pg8::StaticOrder, true>(F.lds, g, S, E);
                }
            } PHASE_END
            PHASE_BEGIN {
                unsigned char* const ws = fresh_args(a)->ws; bf16_t* MIXB = (bf16_t*)(ws + WS_MIXB); const bf16_t* wout_t = (const bf16_t*)(ws + WS_WOUT);
                pg8::Gemm g{MIXB, wout_t, D, D, D, 0}; pg8::StaticOrder S; S.init(CHT, D, F.G, F.bid);
                const float* base = (layer == 0 ? a->x : (const float*)a->out) + (size_t)chunk * CHT * D;
                pg8::EpiResid E{base, a->out + (size_t)chunk * CHT * D};
                pg8::gemm_phase<pg8::EpiResid, pg8::StaticOrder, true>(F.lds, g, S, E);
            } PHASE_END
        }
        PHASE_BEGIN phase_router(F, a, layer); PHASE_END
        PHASE_BEGIN phase_bin(F, a, layer); PHASE_END
        PHASE_BEGIN phase_scatter(F, a, layer); PHASE_END
        PHASE_BEGIN {
            unsigned char* const ws = fresh_args(a)->ws; bf16_t* XS = (bf16_t*)(ws + WS_XS); bf16_t* ACT = (bf16_t*)(ws + WS_ACT); const bf16_t* wgu_t = (const bf16_t*)(ws + WS_WGU); const int* tile_expert = (const int*)(ws + WS_ROUT + RO_TILE);
            const int ntiles = __builtin_amdgcn_readfirstlane(tile_expert[MAXTILES]);
            pg8::Gemm g{XS, wgu_t, D, D, D, (size_t)2 * FF * D}; pg8::MoeOrder S; S.init(ntiles * 256, 2 * FF, F.G, F.bid); S.tile_expert = tile_expert;
            pg8::EpiSwiglu E{ACT};
            pg8::gemm_phase<pg8::EpiSwiglu, pg8::MoeOrder, true>(F.lds, g, S, E);
        } PHASE_END
        PHASE_BEGIN {
            unsigned char* const ws = fresh_args(a)->ws; bf16_t* ACT = (bf16_t*)(ws + WS_ACT); bf16_t* Y = (bf16_t*)(ws + WS_Y); const bf16_t* wd_t = (const bf16_t*)(ws + WS_WD); const int* tile_expert = (const int*)(ws + WS_ROUT + RO_TILE);
            const int ntiles = __builtin_amdgcn_readfirstlane(tile_expert[MAXTILES]);
            pg8::Gemm g{ACT, wd_t, FF, FF, FF, (size_t)D * FF}; pg8::MoeOrder S; S.init(ntiles * 256, D, F.G, F.bid); S.tile_expert = tile_expert;
            pg8::EpiBf16Plain E{Y, D};
            pg8::gemm_phase<pg8::EpiBf16Plain, pg8::MoeOrder, true>(F.lds, g, S, E);
        } PHASE_END
        PHASE_BEGIN phase_combine(F, a, layer); if (layer + 1 < DEPTH) { phase_wconv(F, a, layer + 1); __syncthreads(); } PHASE_END
    }
#undef PHASE_BEGIN
#undef PHASE_END
}

extern "C" void kernel_launch(void* const* d_in, const int* in_sizes, int n_in, void* d_out, int out_size, void* d_ws, size_t ws_size, hipStream_t stream) {
    static int grid = 0;
    if (grid == 0) {
        if (n_in != 21 || in_sizes[0] != NTOK * D || out_size != NTOK * D || ws_size < WS_END) { fprintf(stderr, "kernel_launch: unexpected shapes (n_in %d, in0 %d, out %d, ws %zu); nothing launched\n", n_in, n_in > 0 ? in_sizes[0] : -1, out_size, ws_size); grid = -1; return; }
        int dev = 0, cus = 0, per_cu = 0;
        if (hipGetDevice(&dev) != hipSuccess || hipDeviceGetAttribute(&cus, hipDeviceAttributeMultiprocessorCount, dev) != hipSuccess) { grid = -1; return; }
        if (hipFuncSetAttribute((const void*)mega_fwd, hipFuncAttributeMaxDynamicSharedMemorySize, LDS_BYTES) != hipSuccess) { fprintf(stderr, "kernel_launch: hipFuncSetAttribute failed\n"); grid = -1; return; }
        if (hipOccupancyMaxActiveBlocksPerMultiprocessor(&per_cu, (const void*)mega_fwd, NTHR, LDS_BYTES) != hipSuccess || per_cu < 1) fprintf(stderr, "kernel_launch: occupancy query reports %d blocks per CU\n", per_cu);
        (void)hipGetLastError();
        grid = cus;
    }
    if (grid < 0) return;
    (void)hipMemsetAsync((char*)d_ws + WS_CTL, 0, CTL_BYTES, stream);
    Args a{};
    a.x = (const float*)d_in[0]; a.attn_norm_g = (const float*)d_in[1]; a.w_in = (const float*)d_in[2]; a.gate_bias = (const float*)d_in[3];
    a.moba_q_gain = (const float*)d_in[4]; a.moba_k_gain = (const float*)d_in[5]; a.diff_q_gain = (const float*)d_in[6]; a.diff_k_gain = (const float*)d_in[7];
    a.lq1 = (const float*)d_in[8]; a.lk1 = (const float*)d_in[9]; a.lq2 = (const float*)d_in[10]; a.lk2 = (const float*)d_in[11]; a.diff_head_gain = (const float*)d_in[12];
    a.w_branch = (const float*)d_in[13]; a.w_out = (const float*)d_in[14]; a.ffn_norm_g = (const float*)d_in[15]; a.w_rg = (const float*)d_in[16]; a.w_re = (const float*)d_in[17];
    a.w_eg = (const float*)d_in[18]; a.w_eu = (const float*)d_in[19]; a.w_ed = (const float*)d_in[20];
    a.out = (float*)d_out; a.ws = (unsigned char*)d_ws;
#ifndef MK_SPLIT
    a.step_lo = 0; a.step_hi = NSTEPS;
    hipLaunchKernelGGL(mega_fwd, dim3(grid), dim3(NTHR), LDS_BYTES, stream, a);
#else
    for (int s = 0; s < NSTEPS; ++s) { a.step_lo = s; a.step_hi = s + 1; hipLaunchKernelGGL(mega_fwd, dim3(grid), dim3(NTHR), LDS_BYTES, stream, a); }
#endif
}
```

```cpp
#include <hip/hip_runtime.h>
#include <cstdio>
#include <cstdint>

#define LAS __attribute__((address_space(3)))
typedef unsigned short bf16_t;
typedef short bf16x8 __attribute__((ext_vector_type(8)));
typedef short s16x4 __attribute__((ext_vector_type(4)));
typedef float f32x4 __attribute__((ext_vector_type(4)));
typedef float f32x2 __attribute__((ext_vector_type(2)));
typedef float f32x16 __attribute__((ext_vector_type(16)));
typedef unsigned u32x4 __attribute__((ext_vector_type(4)));
typedef unsigned u32x2 __attribute__((ext_vector_type(2)));
typedef __bf16 bf16x2_t __attribute__((ext_vector_type(2)));
typedef int v8i32 __attribute__((ext_vector_type(8)));
typedef int v4i32 __attribute__((ext_vector_type(4)));

constexpr int D = 2048, BATCH = 16, SEQ = 2048, DEPTH = 2, NTOK = BATCH * SEQ;
constexpr int HD = 128, MIXW = 1024, INC = 9 * MIXW + 3 * D;
constexpr int QP = 9 * MIXW, GP = 3 * D;
constexpr int NEXP = 32, FF = 512, NASSIGN = NTOK * 2;
constexpr int CHB = 8, CHT = CHB * SEQ, NCH = BATCH / CHB;
constexpr int MAXTILES = NASSIGN / 256 + NEXP, MAXSLOTS = MAXTILES * 256;
constexpr float RMS_EPS = 1e-6f;
constexpr float QSCALE2 = 0.08838834764831845f * 1.4426950408889634f;

constexpr size_t MiB = 1u << 20;
constexpr size_t WS_CTL = 0, CTL_BYTES = 4 * MiB;
constexpr size_t WS_WIN = 4 * MiB, WS_WBR = 64 * MiB, WS_WOUT = 76 * MiB, WS_WGU = 84 * MiB, WS_WD = 212 * MiB;
constexpr size_t WS_H = 276 * MiB;
constexpr size_t WS_R = 404 * MiB;
constexpr size_t WS_PROJ = WS_R, WS_GATES = WS_R + 288 * MiB, WS_BR = WS_R + 672 * MiB, WS_MIXB = WS_R, WS_KMEAN = WS_R + 864 * MiB;
constexpr size_t WS_ACT = WS_R + 288 * MiB, WS_Y = WS_R, WS_ROUT = WS_R + 330 * MiB;
constexpr size_t WS_XB = WS_R + 480 * MiB;
constexpr size_t WS_WIN8 = 148 * MiB;
constexpr size_t WS_H8 = WS_R + 866 * MiB;
constexpr size_t WS_END = WS_H8 + 64 * MiB;
constexpr size_t RO_E = 0, RO_W = 1 * MiB, RO_POS = 2 * MiB, RO_SLOT = 3 * MiB, RO_TILE = 4 * MiB, RO_MAP = 4 * MiB + 65536;
constexpr int CW_BAR = 0;
constexpr int CW_WQ = 4096;
constexpr int CW_CNT = 8192;
constexpr int CW_FLAG = 16384;

__device__ __forceinline__ unsigned pk2(float lo, float hi) { f32x2 v = {lo, hi}; bf16x2_t b = __builtin_convertvector(v, bf16x2_t); return __builtin_bit_cast(unsigned, b); }
__device__ __forceinline__ unsigned pk4_fp8(float a, float b, float c, float d) { int r = 0; r = __builtin_amdgcn_cvt_pk_fp8_f32(a, b, r, false); r = __builtin_amdgcn_cvt_pk_fp8_f32(c, d, r, true); return (unsigned)r; }
__device__ __forceinline__ float bf2f(unsigned short b) { return __uint_as_float(((unsigned)b) << 16); }
__device__ __forceinline__ float bflo(unsigned w) { return __uint_as_float(w << 16); }
__device__ __forceinline__ float bfhi(unsigned w) { return __uint_as_float(w & 0xffff0000u); }
__device__ __forceinline__ float shx(float v, int m, int lane) { return __int_as_float(__builtin_amdgcn_ds_bpermute((lane ^ m) << 2, __float_as_int(v))); }
__device__ __forceinline__ int shl_i(int v, int src_lane) { return __builtin_amdgcn_ds_bpermute(src_lane << 2, v); }
__device__ __forceinline__ float wave_sum(float v, int lane) {
#pragma unroll
    for (int o = 1; o < 64; o <<= 1) v += shx(v, o, lane);
    return v;
}
__device__ __forceinline__ float wave_max(float v, int lane) {
#pragma unroll
    for (int o = 1; o < 64; o <<= 1) v = fmaxf(v, shx(v, o, lane));
    return v;
}
__device__ __forceinline__ float fast_exp2(float x) { return __builtin_amdgcn_exp2f(x); }
__device__ __forceinline__ float fast_rcp(float x) { return __builtin_amdgcn_rcpf(x); }
__device__ __forceinline__ unsigned pk4_u8(float a, float b, float c, float d) { unsigned r = 0u;
    r = __builtin_amdgcn_cvt_pk_u8_f32(a * 256.f - 0.5f, 0u, r); r = __builtin_amdgcn_cvt_pk_u8_f32(b * 256.f - 0.5f, 1u, r); r = __builtin_amdgcn_cvt_pk_u8_f32(c * 256.f - 0.5f, 2u, r); r = __builtin_amdgcn_cvt_pk_u8_f32(d * 256.f - 0.5f, 3u, r); return r; }
__device__ __forceinline__ float u8h(unsigned w, int i) { return (float)((w >> (8 * i)) & 255u) + 0.5f; }
__device__ __forceinline__ float sigmoidf_(float x) { return fast_rcp(1.0f + fast_exp2(-1.4426950408889634f * x)); }
__device__ __forceinline__ int lane_id_() { int t; asm volatile("v_mbcnt_lo_u32_b32 %0, -1, 0\n\tv_mbcnt_hi_u32_b32 %0, -1, %0" : "=v"(t)); return t; }
__device__ __forceinline__ bool is_thread0(int wave) { return wave == 0 && lane_id_() == 0; }
__device__ __forceinline__ int fresh_tid(int wave) { int t = lane_id_() + 64 * wave; asm volatile("" : "+v"(t)); return t; }
template <class T> __device__ __forceinline__ T* fresh_ptr(T* p) { asm volatile("" : "+s"(p)); return p; }
__device__ __forceinline__ float uniformf(float v) { return __uint_as_float(__builtin_amdgcn_readfirstlane(__float_as_uint(v))); }
#define LDS_WAIT() asm volatile("s_waitcnt lgkmcnt(0)" ::: "memory")
#define VM_WAIT() asm volatile("s_waitcnt vmcnt(0)" ::: "memory")

#define XB_TMO      128
#define XB_XCNT(j)  (256  + 64 * (j))
#define XB_XSUB(j)  (1280 + 64 * (j))
#define XB_XGEN(j)  (2304 + 64 * (j))
#define XB_TOP      3328
#define XB_TOPGEN   3392
#define XCD_BAR_WORDS 3456
#define XB_SPIN_CAP (1u << 24)
__device__ __forceinline__ unsigned xb_ld(unsigned* p)              { return __hip_atomic_load(p, __ATOMIC_RELAXED, __HIP_MEMORY_SCOPE_AGENT); }
__device__ __forceinline__ unsigned xb_add(unsigned* p, unsigned v) { return __hip_atomic_fetch_add(p, v, __ATOMIC_RELAXED, __HIP_MEMORY_SCOPE_AGENT); }
__device__ __forceinline__ unsigned xb_xcc_id() { return (unsigned)__builtin_amdgcn_s_getreg((3 << 11) | 20) & 0xFu; }
#define XB_SPIN(cond, bar) do { unsigned _sp = 0; while (cond) { __builtin_amdgcn_s_sleep(1); \
    if ((++_sp & 255u) == 0u) { if (xb_ld(&(bar)[XB_TMO])) break; if (_sp > XB_SPIN_CAP) { atomicAdd(&(bar)[XB_TMO], 1u); break; } } } } while (0)
struct XcdBarrier { unsigned* bar; unsigned x; volatile LAS unsigned* st; int wave; };
__device__ __forceinline__ XcdBarrier xcd_barrier_post(unsigned* bar, volatile LAS unsigned* st, int wave) {
    XcdBarrier b; b.bar = bar; b.x = xb_xcc_id(); b.st = st; b.wave = wave;
    if (is_thread0(wave)) (void)xb_add(&bar[XB_XCNT(b.x)], 1u);
    return b;
}
__device__ __forceinline__ void xcd_barrier_complete(unsigned* bar, unsigned x, unsigned& nloc, unsigned& nx) {
    const unsigned G = gridDim.x * gridDim.y * gridDim.z;
    unsigned sum, cnt, mine, sp = 0u;
    for (;;) {
        sum = 0u; cnt = 0u; mine = 0u;
#pragma unroll
        for (unsigned j = 0; j < 16; ++j) { const unsigned c = xb_ld(&bar[XB_XCNT(j)]); sum += c; cnt += (c > 0u) ? 1u : 0u; mine = (j == x) ? c : mine; }
        if (sum == G) break;
        __builtin_amdgcn_s_sleep(1);
        if ((++sp & 255u) == 0u) { if (xb_ld(&bar[XB_TMO])) break; if (sp > XB_SPIN_CAP) { atomicAdd(&bar[XB_TMO], 1u); break; } }
    }
    nloc = mine > 0u ? mine : 1u; nx = cnt > 0u ? cnt : 1u;
}
__device__ __forceinline__ void xcd_barrier(const XcdBarrier& b) {
    asm volatile("s_waitcnt vmcnt(0)" ::: "memory");
    __syncthreads();
    if (is_thread0(b.wave)) {
        unsigned* bar = b.bar;
        __builtin_amdgcn_s_waitcnt(0);
        unsigned nloc = b.st[0], nx = b.st[1];
        if (nloc == 0u) { xcd_barrier_complete(bar, b.x, nloc, nx); b.st[0] = nloc; b.st[1] = nx; }
        const unsigned old = xb_add(&bar[XB_XSUB(b.x)], 1u);
        const unsigned gen = old / nloc;
        if (old + 1u == (gen + 1u) * nloc) {
            __builtin_amdgcn_fence(__ATOMIC_RELEASE, "agent");
            asm volatile("s_waitcnt vmcnt(0)" ::: "memory");
            const unsigned og = xb_add(&bar[XB_TOP], 1u);
            const unsigned tg = og / nx;
            if (og + 1u == (tg + 1u) * nx) xb_add(&bar[XB_TOPGEN], 1u);
            else XB_SPIN(xb_ld(&bar[XB_TOPGEN]) == tg, bar);
            __builtin_amdgcn_fence(__ATOMIC_ACQUIRE, "agent");
            xb_add(&bar[XB_XGEN(b.x)], 1u);
            asm volatile("s_waitcnt vmcnt(0)" ::: "memory");
        } else {
            XB_SPIN(xb_ld(&bar[XB_XGEN(b.x)]) == gen, bar);
            __builtin_amdgcn_fence(__ATOMIC_ACQUIRE, "agent");
            asm volatile("s_waitcnt vmcnt(0)" ::: "memory");
        }
    }
    __syncthreads();
}

namespace pg8 {
constexpr int BM = 256, BK = 64, HALF = 128, HTB = HALF * BK * 2, STAGE_BYTES = 8 * HTB, NXCD = 8, WGM = 8;
__host__ __device__ __forceinline__ int lds_byte(int r, int c) { const int st = (r >> 4) * 2 + (c >> 5), rr = r & 15, cc = c & 31, ob = rr * 64 + cc * 2; return st * 1024 + (ob ^ (((ob >> 9) & 1) << 5)); }
__host__ __device__ __forceinline__ void stage_rc(int b, int& R, int& C) { const int st = b / 1024, sb = b % 1024, swz = sb ^ (((sb >> 9) & 1) << 5); R = (st >> 1) * 16 + swz / 64; C = (st & 1) * 32 + (swz % 64) / 2; }
__host__ __device__ __forceinline__ int perm32(int rho) { const int n = rho >> 4, i = rho & 15; return 8 * (i >> 2) + 4 * n + (i & 3); }

struct Unit { int pm, pn, be; };
struct Gemm { const bf16_t* A; const bf16_t* Bt; int lda, ldb, K; size_t bstride; size_t astride = 0; const int* arow = nullptr; };

struct StaticOrder {
    int nM, nN, nwg, G, c;
    __device__ void init(int M, int N, int G_, int c_) { nM = M / BM; nN = N / BM; nwg = nM * nN; G = G_; c = c_; }
    __device__ bool next(int i, Unit& u) const {
        const long L = (long)i * G + c; if (L >= nwg) return false;
        int wgid = (int)L; { const int q = nwg / NXCD, r = nwg % NXCD, xcd = wgid % NXCD, off = wgid / NXCD; wgid = (xcd < r ? xcd * (q + 1) : r * (q + 1) + (xcd - r) * q) + off; }
        const int nig = WGM * nN, gid = wgid / nig, fm = gid * WGM, gsz = (nM - fm) < WGM ? (nM - fm) : WGM;
        u.pm = fm + ((wgid % nig) % gsz); u.pn = (wgid % nig) / gsz; u.be = 0; return true;
    }
};
struct BatchOrder : StaticOrder {
    int nb;
    __device__ bool next(int i, Unit& u) const {
        const long L = (long)i * G + c; if (L >= (long)nb * nwg) return false;
        const int b = (int)(L / nwg), l = (int)(L - (long)b * nwg);
        StaticOrder S1 = *this; S1.c = l % G; if (!S1.StaticOrder::next(l / G, u)) return false;
        u.be = b; return true;
    }
};
struct ChainOrder : StaticOrder {
    int nb;
    __device__ bool next(int i, Unit& u) const { const int j = i / nb, b = i - j * nb; if (!StaticOrder::next(j, u)) return false; u.be = b; return true; }
};
struct MoeOrder : StaticOrder {
    const int* tile_expert;
    __device__ bool next(int i, Unit& u) const {
        if (!StaticOrder::next(i, u)) return false;
        u.be = __builtin_amdgcn_readfirstlane(tile_expert[u.pm]); return true;
    }
};

template <class Epi, class Sched, bool ALIGN_EPI, bool FP8 = false, bool GATHER = false, int SC8 = 0x00007f79>
__device__ __forceinline__ void gemm_phase(LAS unsigned char* lds, const Gemm g, const Sched& S, const Epi& E, int wave_) {
    const int tid = fresh_tid(wave_), wid = __builtin_amdgcn_readfirstlane(tid >> 6), lane = tid & 63, wr = wid >> 2, wc = wid & 3, fr = lane & 15, fq = lane >> 4;
    const int K = g.K, nt = K / BK;
    unsigned voffA[2], voffB[2]; int rowA[2]; unsigned colA[2];
#pragma unroll
    for (int i = 0; i < 2; ++i) { int R, C; stage_rc(tid * 16 + i * 8192, R, C); const int Rb = Epi::PERM ? ((R & ~31) + perm32(R & 31)) : R;
        voffA[i] = (unsigned)(R * g.lda + C) * 2u; voffB[i] = (unsigned)(Rb * g.ldb + C) * 2u; rowA[i] = R; colA[i] = (unsigned)C * 2u; }
    unsigned gA0[2], gA1[2], nG0[2], nG1[2];
    auto gather_offs = [&](int pm, unsigned (&o0)[2], unsigned (&o1)[2]) {
#pragma unroll
        for (int i = 0; i < 2; ++i) { const int r0 = g.arow[pm * BM + rowA[i]], r1 = g.arow[pm * BM + HALF + rowA[i]];
            o0[i] = (unsigned)(r0 < 0 ? 0 : r0) * (unsigned)(g.lda * 2) + colA[i]; o1[i] = (unsigned)(r1 < 0 ? 0 : r1) * (unsigned)(g.lda * 2) + colA[i]; } };
    const size_t kstep = (size_t)(BK * 2);
    const size_t hsA = (size_t)HALF * g.lda * 2, hsB = (size_t)HALF * g.ldb * 2;
    const unsigned ldsw = (unsigned)wid * 1024u;
    const int aoff = lds_byte(wr * 64 + fr, fq * 8), boff = lds_byte(wc * 32 + fr, fq * 8);
#define PG8_SA(b, h) (((b) * 2 + (h)) * HTB)
#define PG8_SB(b, h) ((4 + (b) * 2 + (h)) * HTB)
#define PG8_STAGE(bufoff, gbase, voff) do { _Pragma("unroll") for (int _i = 0; _i < 2; ++_i) \
        __builtin_amdgcn_global_load_lds((const unsigned*)((const char*)(gbase) + (voff)[_i]), (LAS unsigned*)(lds + (bufoff) + ldsw + _i * 8192), 16, 0, 0); } while (0)
#define PG8_STA(bufoff, h, ptr, nx) do { if constexpr (GATHER) { unsigned vo_[2]; _Pragma("unroll") for (int _j = 0; _j < 2; ++_j) vo_[_j] = (nx) ? ((h) ? nG1[_j] : nG0[_j]) : ((h) ? gA1[_j] : gA0[_j]); PG8_STAGE(bufoff, ptr, vo_); } \
        else PG8_STAGE(bufoff, (ptr) + (h) * hsA, voffA); } while (0)
#define PG8_LDA(dst, b, h) do { _Pragma("unroll") for (int m = 0; m < 4; ++m) { if constexpr (FP8) { const v4i32 f0_ = *(const LAS v4i32*)(lds + PG8_SA(b, h) + aoff + m * 2048), f1_ = *(const LAS v4i32*)(lds + PG8_SA(b, h) + aoff + m * 2048 + 1024); \
            dst##8[m] = __builtin_shufflevector(f0_, f1_, 0, 1, 2, 3, 4, 5, 6, 7); } else { _Pragma("unroll") for (int k = 0; k < 2; ++k) dst[m][k] = *(const LAS bf16x8*)(lds + PG8_SA(b, h) + aoff + m * 2048 + k * 1024); } } } while (0)
#define PG8_LDB(dst, b, h) do { _Pragma("unroll") for (int n = 0; n < 2; ++n) { if constexpr (FP8) { const v4i32 f0_ = *(const LAS v4i32*)(lds + PG8_SB(b, h) + boff + n * 2048), f1_ = *(const LAS v4i32*)(lds + PG8_SB(b, h) + boff + n * 2048 + 1024); \
            dst##8[n] = __builtin_shufflevector(f0_, f1_, 0, 1, 2, 3, 4, 5, 6, 7); } else { _Pragma("unroll") for (int k = 0; k < 2; ++k) dst[n][k] = *(const LAS bf16x8*)(lds + PG8_SB(b, h) + boff + n * 2048 + k * 1024); } } } while (0)
#define PG8_MMA(ai, bj, At, Bt) do { __builtin_amdgcn_s_setprio(1); _Pragma("unroll") for (int m = 0; m < 4; ++m) _Pragma("unroll") for (int n = 0; n < 2; ++n) { \
        if constexpr (FP8) asm volatile("v_mfma_scale_f32_16x16x128_f8f6f4 %0, %1, %2, %0, %3, %3 op_sel:[0,1,0] op_sel_hi:[0,0,0]" : "+v"(acc[ai][bj][m][n]) : "v"(Bt##8[n]), "v"(At##8[m]), "v"(sc8_)); \
        else { _Pragma("unroll") for (int k = 0; k < 2; ++k) acc[ai][bj][m][n] = __builtin_amdgcn_mfma_f32_16x16x32_bf16(Bt[n][k], At[m][k], acc[ai][bj][m][n], 0, 0, 0); } } \
        __builtin_amdgcn_s_setprio(0); } while (0)
#define PG8_WAIT_V(n) asm volatile("s_waitcnt vmcnt(" #n ")" ::: "memory")
#define PG8_WAIT_L(n) asm volatile("s_waitcnt lgkmcnt(" #n ")" ::: "memory")
#define PG8_BAR __builtin_amdgcn_s_barrier()
#define PG8_SCHED __builtin_amdgcn_sched_barrier(0)
    Unit cur, nxt; int ui = 0;
    if (!S.next(0, cur)) return;
    f32x4 acc[2][2][4][2];
#pragma unroll
    for (int a = 0; a < 2; ++a)
#pragma unroll
        for (int b = 0; b < 2; ++b)
#pragma unroll
            for (int m = 0; m < 4; ++m)
#pragma unroll
                for (int n = 0; n < 2; ++n) acc[a][b][m][n] = (f32x4){0.f, 0.f, 0.f, 0.f};
    const int sc8_ = SC8;
    bf16x8 At[4][2], B0[2][2], B1[2][2]; v8i32 At8[4], B08[2], B18[2];
    const char* cA = (const char*)g.A + ((size_t)cur.be * g.astride) * 2 + (GATHER ? (size_t)0 : (size_t)cur.pm * 2 * hsA); if constexpr (GATHER) gather_offs(cur.pm, gA0, gA1);
    const char* cB = (const char*)g.Bt + ((size_t)cur.be * g.bstride) * 2 + (size_t)cur.pn * 2 * hsB;
    PG8_STAGE(PG8_SB(0, 0), cB, voffB); PG8_STAGE(PG8_SB(0, 1), cB + hsB, voffB); PG8_STA(PG8_SA(0, 0), 0, cA, false); PG8_STA(PG8_SA(0, 1), 1, cA, false);
    if (wr == 1) PG8_BAR;
    PG8_WAIT_V(2); PG8_BAR;
    PG8_STAGE(PG8_SB(1, 0), cB + kstep, voffB); PG8_STA(PG8_SA(1, 0), 0, cA + kstep, false); PG8_STAGE(PG8_SB(1, 1), cB + hsB + kstep, voffB);
    PG8_WAIT_V(6); PG8_BAR;
    for (;;) {
        const bool has_next = S.next(ui + 1, nxt);
        const char* nA = has_next ? (const char*)g.A + ((size_t)nxt.be * g.astride) * 2 + (GATHER ? (size_t)0 : (size_t)nxt.pm * 2 * hsA) : cA;
        if constexpr (GATHER) { if (has_next) gather_offs(nxt.pm, nG0, nG1); else { nG0[0] = gA0[0]; nG0[1] = gA0[1]; nG1[0] = gA1[0]; nG1[1] = gA1[1]; } }
        const char* nB = has_next ? (const char*)g.Bt + ((size_t)nxt.be * g.bstride) * 2 + (size_t)nxt.pn * 2 * hsB : cB;
        for (int t = 0; t < nt; t += 2) {
            const bool last = (t == nt - 2);
            const char* a1 = cA + (size_t)(t + 1) * kstep;
            const char* a2 = last ? nA : cA + (size_t)(t + 2) * kstep; const char* b2 = last ? nB : cB + (size_t)(t + 2) * kstep;
            const char* a3 = a2 + kstep; const char* b3 = b2 + kstep;
            PG8_LDB(B0, 0, 0); PG8_LDB(B1, 0, 1); PG8_SCHED; PG8_LDA(At, 0, 0); PG8_STA(PG8_SA(1, 1), 1, a1, false);
            PG8_WAIT_V(8); PG8_WAIT_L(0); PG8_BAR; PG8_MMA(0, 0, At, B0); PG8_MMA(0, 1, At, B1); PG8_BAR; PG8_SCHED;
            PG8_LDA(At, 0, 1); PG8_STAGE(PG8_SB(0, 0), b2, voffB); PG8_STAGE(PG8_SB(0, 1), b2 + hsB, voffB); PG8_STA(PG8_SA(0, 0), 0, a2, last);
            PG8_WAIT_V(8); PG8_WAIT_L(0); PG8_BAR; PG8_MMA(1, 0, At, B0); PG8_MMA(1, 1, At, B1); PG8_BAR; PG8_SCHED;
            PG8_LDB(B0, 1, 0); PG8_LDB(B1, 1, 1); PG8_SCHED; PG8_LDA(At, 1, 0); PG8_STA(PG8_SA(0, 1), 1, a2, last);
            PG8_WAIT_V(8); PG8_WAIT_L(0); PG8_BAR; PG8_MMA(0, 0, At, B0); PG8_MMA(0, 1, At, B1); PG8_BAR; PG8_SCHED;
            PG8_LDA(At, 1, 1); PG8_STAGE(PG8_SB(1, 0), b3, voffB); PG8_STAGE(PG8_SB(1, 1), b3 + hsB, voffB); PG8_STA(PG8_SA(1, 0), 0, a3, last);
            PG8_WAIT_V(8); PG8_WAIT_L(0); PG8_BAR; PG8_MMA(1, 0, At, B0); PG8_MMA(1, 1, At, B1); PG8_BAR; PG8_SCHED;
        }
        if constexpr (ALIGN_EPI) { if (wr == 0) PG8_BAR; }
        if constexpr (FP8) asm volatile("s_nop 15\n\ts_nop 15" ::: "memory");
        bool keep_acc = false;
#ifdef PROBE_EPI
        unsigned long long tq_ = 0; if (((PROBE_EPI >> Epi::PID) & 1) && is_thread0(wid)) tq_ = __builtin_amdgcn_s_memrealtime();
#endif
        { const int l2_ = fresh_tid(wid) & 63; if constexpr (Epi::INPLACE) keep_acc = E.link(acc, cur, wr, wc, l2_ & 15, l2_ >> 4); else E(acc, cur, wr, wc, l2_ & 15, l2_ >> 4); }
#ifdef PROBE_EPI
        if (((PROBE_EPI >> Epi::PID) & 1) && is_thread0(wid)) { asm volatile("s_waitcnt vmcnt(0)" ::: "memory"); volatile LAS unsigned* mp = (volatile LAS unsigned*)(lds + (147456 - 1024)) + 16; mp[0] = mp[0] + (unsigned)(__builtin_amdgcn_s_memrealtime() - tq_); }
#endif
        if (!has_next) break;
        if (!keep_acc)
#pragma unroll
        for (int a = 0; a < 2; ++a)
#pragma unroll
            for (int b = 0; b < 2; ++b)
#pragma unroll
                for (int m = 0; m < 4; ++m)
#pragma unroll
                    for (int n = 0; n < 2; ++n) acc[a][b][m][n] = (f32x4){0.f, 0.f, 0.f, 0.f};
        cur = nxt; cA = nA; cB = nB; ++ui;
        if constexpr (GATHER) { gA0[0] = nG0[0]; gA0[1] = nG0[1]; gA1[0] = nG1[0]; gA1[1] = nG1[1]; }
        if constexpr (ALIGN_EPI) { if (wr == 1) PG8_BAR; }
    }
    PG8_WAIT_V(0);
    if constexpr (!ALIGN_EPI) { if (wr == 0) PG8_BAR; }
    PG8_BAR;
#undef PG8_SA
#undef PG8_SB
#undef PG8_STAGE
#undef PG8_STA
#undef PG8_LDA
#undef PG8_LDB
#undef PG8_MMA
#undef PG8_WAIT_V
#undef PG8_WAIT_L
#undef PG8_BAR
#undef PG8_SCHED
}

struct EpiBf16Plain {
    static constexpr int PID = 0; static constexpr bool PERM = true; static constexpr bool INPLACE = false;
    bf16_t* O; int ldc;
    __device__ __forceinline__ void operator()(const f32x4 (&acc)[2][2][4][2], const Unit& u, int wr, int wc, int fr_in, int fq_in) const {
        int fr = fr_in, fq = fq_in; asm volatile("" : "+v"(fr), "+v"(fq));
        const int row0 = u.pm * BM + wr * 64 + fr; const int col0 = u.pn * BM + wc * 32 + 8 * fq;
#pragma unroll
        for (int ai = 0; ai < 2; ++ai)
#pragma unroll
            for (int m = 0; m < 4; ++m) { bf16_t* rowp = O + (size_t)(row0 + ai * HALF + m * 16) * ldc + col0;
#pragma unroll
                for (int bj = 0; bj < 2; ++bj) { const f32x4 v0 = acc[ai][bj][m][0], v1 = acc[ai][bj][m][1];
                    u32x4 w; w.x = pk2(v0[0], v0[1]); w.y = pk2(v0[2], v0[3]); w.z = pk2(v1[0], v1[1]); w.w = pk2(v1[2], v1[3]);
                    *(u32x4*)(rowp + bj * HALF) = w; } }
    }
};
struct EpiProj {
    static constexpr int PID = 1; static constexpr bool PERM = true; static constexpr bool INPLACE = false;
    bf16_t* O; const float* gbias; const float* gq_a; const float* gk_a; const float* gq_b; const float* gk_b; float* kmean; LAS unsigned char* tab; unsigned long long segmap; size_t gofs;
    __device__ __forceinline__ void operator()(const f32x4 (&acc)[2][2][4][2], const Unit& u, int wr, int wc, int fr, int fq) const {
        const int row0 = u.pm * BM + wr * 64 + fr; const int coltL = u.pn * BM;
        const int seg = (int)((segmap >> (4 * (coltL >> 10))) & 15ull), colt = seg * MIXW + (coltL & (MIXW - 1)), col0 = colt + wc * 32 + 8 * fq;
        const bool isnorm = (seg == 0) | (seg == 1) | (seg == 3) | (seg == 4);
        if (!isnorm) {
            const bool isgate = colt >= 9 * MIXW;
            if (isgate) {
                f32x4 bv[2][2];
#pragma unroll
                for (int bj = 0; bj < 2; ++bj)
#pragma unroll
                    for (int n = 0; n < 2; ++n) bv[bj][n] = *(const f32x4*)(gbias + (col0 - 9 * MIXW) + bj * HALF + 4 * n);
                unsigned char* gbase = (unsigned char*)O + gofs + (size_t)(col0 - 9 * MIXW);
#pragma unroll
                for (int ai = 0; ai < 2; ++ai)
#pragma unroll
                    for (int m = 0; m < 4; ++m) { unsigned char* rowp = gbase + (size_t)(row0 + ai * HALF + m * 16) * GP;
#pragma unroll
                        for (int bj = 0; bj < 2; ++bj) { const f32x4 v0 = acc[ai][bj][m][0] + bv[bj][0], v1 = acc[ai][bj][m][1] + bv[bj][1];
                            u32x2 w; w.x = pk4_u8(sigmoidf_(v0[0]), sigmoidf_(v0[1]), sigmoidf_(v0[2]), sigmoidf_(v0[3])); w.y = pk4_u8(sigmoidf_(v1[0]), sigmoidf_(v1[1]), sigmoidf_(v1[2]), sigmoidf_(v1[3]));
                            *(u32x2*)(rowp + bj * HALF) = w; } }
                return;
            }
#pragma unroll
            for (int ai = 0; ai < 2; ++ai)
#pragma unroll
                for (int m = 0; m < 4; ++m) { bf16_t* rowp = O + (size_t)(row0 + ai * HALF + m * 16) * QP + col0;
#pragma unroll
                    for (int bj = 0; bj < 2; ++bj) { const f32x4 v0 = acc[ai][bj][m][0], v1 = acc[ai][bj][m][1];
                        u32x4 w; w.x = pk2(v0[0], v0[1]); w.y = pk2(v0[2], v0[3]); w.z = pk2(v1[0], v1[1]); w.w = pk2(v1[2], v1[3]);
                        *(u32x4*)(rowp + bj * HALF) = w; } }
            return;
        }
        f32x4 g0, g1; const int go = 32 * wc + 8 * fq;
        if (seg == 0)      { g0 = *(const f32x4*)(gq_a + go) * QSCALE2; g1 = *(const f32x4*)(gq_a + go + 4) * QSCALE2; }
        else if (seg == 1) { g0 = *(const f32x4*)(gk_a + go);           g1 = *(const f32x4*)(gk_a + go + 4); }
        else if (seg == 3) { g0 = *(const f32x4*)(gq_b + go) * QSCALE2; g1 = *(const f32x4*)(gq_b + go + 4) * QSCALE2; }
        else               { g0 = *(const f32x4*)(gk_b + go);           g1 = *(const f32x4*)(gk_b + go + 4); }
        LAS float* T = (LAS float*)tab;
        LAS float* KS = (LAS float*)(tab + 8192);
#pragma unroll
        for (int ai = 0; ai < 2; ++ai)
#pragma unroll
            for (int m = 0; m < 4; ++m)
#pragma unroll
                for (int bj = 0; bj < 2; ++bj) { const f32x4 v0 = acc[ai][bj][m][0], v1 = acc[ai][bj][m][1];
                    float ss = (v0[0] * v0[0] + v0[1] * v0[1]) + (v0[2] * v0[2] + v0[3] * v0[3]) + (v1[0] * v1[0] + v1[1] * v1[1]) + (v1[2] * v1[2] + v1[3] * v1[3]);
                    ss += shx(ss, 16, fq * 16 + fr); ss += shx(ss, 32, fq * 16 + fr);
                    if (fq == 0) T[((ai * HALF + wr * 64 + m * 16 + fr) * 2 + bj) * 4 + wc] = ss; }
        asm volatile("s_waitcnt lgkmcnt(0)" ::: "memory"); __builtin_amdgcn_s_barrier(); asm volatile("" ::: "memory");
        float cs[2][8];
#pragma unroll
        for (int bj = 0; bj < 2; ++bj)
#pragma unroll
            for (int j = 0; j < 8; ++j) cs[bj][j] = 0.f;
#pragma unroll
        for (int ai = 0; ai < 2; ++ai)
#pragma unroll
            for (int m = 0; m < 4; ++m) { const int rl = ai * HALF + wr * 64 + m * 16 + fr; bf16_t* rowp = O + (size_t)(u.pm * BM + rl) * QP + col0;
#pragma unroll
                for (int bj = 0; bj < 2; ++bj) { const f32x4 t = *(const LAS f32x4*)(T + (rl * 2 + bj) * 4);
                    const float rstd = 1.0f / sqrtf(((t.x + t.y) + (t.z + t.w)) * (1.f / HD) + RMS_EPS);
                    const f32x4 y0 = acc[ai][bj][m][0] * rstd * g0, y1 = acc[ai][bj][m][1] * rstd * g1;
                    cs[bj][0] += y0[0]; cs[bj][1] += y0[1]; cs[bj][2] += y0[2]; cs[bj][3] += y0[3]; cs[bj][4] += y1[0]; cs[bj][5] += y1[1]; cs[bj][6] += y1[2]; cs[bj][7] += y1[3];
                    u32x4 w; w.x = pk2(y0[0], y0[1]); w.y = pk2(y0[2], y0[3]); w.z = pk2(y1[0], y1[1]); w.w = pk2(y1[2], y1[3]);
                    *(u32x4*)(rowp + bj * HALF) = w; } }
        if (seg == 1) {
#pragma unroll
            for (int bj = 0; bj < 2; ++bj)
#pragma unroll
                for (int j = 0; j < 8; ++j) { float c = cs[bj][j]; c += shx(c, 1, fq * 16 + fr); c += shx(c, 2, fq * 16 + fr); c += shx(c, 4, fq * 16 + fr); c += shx(c, 8, fq * 16 + fr); cs[bj][j] = c; }
            if (fr == 0) {
#pragma unroll
                for (int bj = 0; bj < 2; ++bj) { LAS float* q = KS + wr * 256 + bj * HALF + wc * 32 + 8 * fq;
                    *(LAS f32x4*)q = (f32x4){cs[bj][0], cs[bj][1], cs[bj][2], cs[bj][3]}; *(LAS f32x4*)(q + 4) = (f32x4){cs[bj][4], cs[bj][5], cs[bj][6], cs[bj][7]}; }
            }
            asm volatile("s_waitcnt lgkmcnt(0)" ::: "memory"); __builtin_amdgcn_s_barrier(); asm volatile("" ::: "memory");
            const int tid = (wr * 4 + wc) * 64 + fq * 16 + fr;
            if (tid < 256) { const int c = colt - MIXW + tid;
                kmean[(((size_t)(u.pm >> 3) * 8 + (c >> 7)) * 8 + (u.pm & 7)) * HD + (c & 127)] = (KS[tid] + KS[256 + tid]) * (1.f / 256.f); }
        }
    }
};
struct EpiGateChain {
    static constexpr int PID = 2; static constexpr bool PERM = true; static constexpr bool INPLACE = true;
    const unsigned char* gate0; bf16_t* mixb;
    __device__ __forceinline__ bool link(f32x4 (&acc)[2][2][4][2], const Unit& u, int wr, int wc, int fr, int fq) const {
        const int row0 = u.pm * BM + wr * 64 + fr, col0 = u.pn * BM + wc * 32 + 8 * fq; const int b = u.be; const bool last = (b == 2);
        const unsigned char* ga = gate0 + b * D + col0; const unsigned char* gb = gate0 + (b + 1) * D + col0;
#pragma unroll
        for (int ai = 0; ai < 2; ++ai) {
            u32x2 g1[4][2], g2[4][2];
#pragma unroll
            for (int m = 0; m < 4; ++m) { const size_t row = (size_t)(row0 + ai * HALF + m * 16);
#pragma unroll
                for (int bj = 0; bj < 2; ++bj) { g1[m][bj] = *(const u32x2*)(ga + row * GP + bj * HALF);
                    if (!last) g2[m][bj] = *(const u32x2*)(gb + row * GP + bj * HALF); else g2[m][bj] = (u32x2){0u, 0u}; } }
#pragma unroll
            for (int m = 0; m < 4; ++m) { const size_t row = (size_t)(row0 + ai * HALF + m * 16);
#pragma unroll
                for (int bj = 0; bj < 2; ++bj) { const u32x2 p = g1[m][bj], q = g2[m][bj];
                    f32x4 r0, r1;
#pragma unroll
                    for (int j = 0; j < 4; ++j) { r0[j] = u8h(p.x, j) * (last ? (1.f / 256.f) : fast_rcp(u8h(q.x, j))); r1[j] = u8h(p.y, j) * (last ? (1.f / 256.f) : fast_rcp(u8h(q.y, j))); }
                    acc[ai][bj][m][0] = acc[ai][bj][m][0] * r0; acc[ai][bj][m][1] = acc[ai][bj][m][1] * r1;
                    if (last) { const f32x4 v0 = acc[ai][bj][m][0], v1 = acc[ai][bj][m][1];
                        u32x4 o; o.x = pk2(v0[0], v0[1]); o.y = pk2(v0[2], v0[3]); o.z = pk2(v1[0], v1[1]); o.w = pk2(v1[2], v1[3]);
                        *(u32x4*)(mixb + row * D + col0 + bj * HALF) = o; } } }
            asm volatile("" ::: "memory");
        }
        return !last;
    }
};
struct EpiResid {
    static constexpr int PID = 3; static constexpr bool PERM = true; static constexpr bool INPLACE = false;
    bf16_t* xb;
    __device__ __forceinline__ void operator()(const f32x4 (&acc)[2][2][4][2], const Unit& u, int wr, int wc, int fr_in, int fq_in) const {
        int fr = fr_in, fq = fq_in; asm volatile("" : "+v"(fr), "+v"(fq));
        const int row0 = u.pm * BM + wr * 64 + fr, col0 = u.pn * BM + wc * 32 + 8 * fq;
#pragma unroll
        for (int ai = 0; ai < 2; ++ai) {
            u32x4 bs[4][2];
#pragma unroll
            for (int m = 0; m < 4; ++m) { const size_t off = (size_t)(row0 + ai * HALF + m * 16) * D + col0;
#pragma unroll
                for (int bj = 0; bj < 2; ++bj) bs[m][bj] = *(const u32x4*)(xb + off + bj * HALF); }
#pragma unroll
            for (int m = 0; m < 4; ++m) { const size_t off = (size_t)(row0 + ai * HALF + m * 16) * D + col0;
#pragma unroll
                for (int bj = 0; bj < 2; ++bj) { const f32x4 v0 = acc[ai][bj][m][0], v1 = acc[ai][bj][m][1]; const u32x4 b = bs[m][bj];
                    u32x4 o; o.x = pk2(v0[0] + bflo(b.x), v0[1] + bfhi(b.x)); o.y = pk2(v0[2] + bflo(b.y), v0[3] + bfhi(b.y)); o.z = pk2(v1[0] + bflo(b.z), v1[1] + bfhi(b.z)); o.w = pk2(v1[2] + bflo(b.w), v1[3] + bfhi(b.w));
                    *(u32x4*)(xb + off + bj * HALF) = o; } }
            asm volatile("" ::: "memory");
        }
    }
};
struct EpiSwiglu {
    static constexpr int PID = 4; static constexpr bool PERM = true; static constexpr bool INPLACE = false;
    unsigned char* act;
    __device__ __forceinline__ void operator()(const f32x4 (&acc)[2][2][4][2], const Unit& u, int wr, int wc, int fr_in, int fq_in) const {
        int fr = fr_in, fq = fq_in; asm volatile("" : "+v"(fr), "+v"(fq));
        const int row0 = u.pm * BM + wr * 64 + fr; const int col0 = u.pn * BM + wc * 32 + 8 * fq;
#pragma unroll
        for (int ai = 0; ai < 2; ++ai)
#pragma unroll
            for (int m = 0; m < 4; ++m) { unsigned char* rowp = act + (size_t)(row0 + ai * HALF + m * 16) * FF + (col0 >> 1);
#pragma unroll
                for (int bj = 0; bj < 2; ++bj) { const f32x4 v0 = acc[ai][bj][m][0], v1 = acc[ai][bj][m][1];
                    const float a0 = v0[0] * sigmoidf_(v0[0]) * v0[1], a1 = v0[2] * sigmoidf_(v0[2]) * v0[3];
                    const float a2 = v1[0] * sigmoidf_(v1[0]) * v1[1], a3 = v1[2] * sigmoidf_(v1[2]) * v1[3];
                    *(unsigned*)(rowp + bj * (HALF / 2)) = pk4_fp8(a0 * 16.f, a1 * 16.f, a2 * 16.f, a3 * 16.f); } }
    }
};
}
constexpr int NWAVES = 8, NTHR = 512;
constexpr int RING_BYTES = 131072;
constexpr int MISC_OFF = 147456 - 1024;
constexpr int XTRA_OFF = RING_BYTES;
constexpr int LDS_BYTES = 147456 + 9216;
constexpr int LDS_BYTES_OLD_ = 147456;

struct Args {
    const float* x; const float* attn_norm_g; const float* w_in; const float* gate_bias;
    const float* moba_q_gain; const float* moba_k_gain; const float* diff_q_gain; const float* diff_k_gain;
    const float* lq1; const float* lk1; const float* lq2; const float* lk2; const float* diff_head_gain;
    const float* w_branch; const float* w_out; const float* ffn_norm_g; const float* w_rg; const float* w_re;
    const float* w_eg; const float* w_eu; const float* w_ed;
    float* out; unsigned char* ws;
    int step_lo, step_hi;
};

typedef const __attribute__((address_space(4))) Args* KArgs;
__device__ __forceinline__ KArgs fresh_args(KArgs p) { asm volatile("" : "+s"(p)); return p; }

#ifdef PROBE_SUB
#define SUBP_BEGIN(bit) unsigned long long sp_t_##bit = 0; if (((PROBE_SUB >> (bit)) & 1) && is_thread0(F.wave)) sp_t_##bit = __builtin_amdgcn_s_memrealtime();
#define SUBP_END(bit) if (((PROBE_SUB >> (bit)) & 1) && is_thread0(F.wave)) { const unsigned d_ = (unsigned)(__builtin_amdgcn_s_memrealtime() - sp_t_##bit); F.MISC[16] = F.MISC[16] + d_; }
#else
#define SUBP_BEGIN(bit)
#define SUBP_END(bit)
#endif
struct Frame {
    LAS unsigned char* lds; volatile LAS unsigned* MISC; unsigned* ctl;
    int tid, lane, wave, G, bid;
};

__device__ __forceinline__ void wconv_item(const float* W, int K, int N, bf16_t* WT, int row_off, int row_mul, LAS float* scr, int item, int lane) {
    const int nblk = N / 32, kb = item / nblk, nb = item % nblk, k0 = 64 * kb, n0 = 32 * nb;
    { f32x4 t[8];
#pragma unroll
      for (int i = 0; i < 8; ++i) t[i] = *(const f32x4*)(W + (size_t)(k0 + 8 * i + (lane >> 3)) * N + n0 + 4 * (lane & 7));
#pragma unroll
      for (int i = 0; i < 8; ++i) { LAS float* q = scr + (8 * i + (lane >> 3)) * 33 + 4 * (lane & 7); q[0] = t[i].x; q[1] = t[i].y; q[2] = t[i].z; q[3] = t[i].w; } }
    LDS_WAIT(); asm volatile("" ::: "memory");
    const int c = lane & 7;
#pragma unroll
    for (int j = 0; j < 4; ++j) { const int n = (lane >> 3) + 8 * j; const LAS float* s = scr + (8 * c) * 33 + n;
        u32x4 o; o.x = pk2(s[0 * 33], s[1 * 33]); o.y = pk2(s[2 * 33], s[3 * 33]); o.z = pk2(s[4 * 33], s[5 * 33]); o.w = pk2(s[6 * 33], s[7 * 33]);
        *(u32x4*)(WT + (size_t)(row_off + (n0 + n) * row_mul) * K + k0 + 8 * c) = o; }
    LDS_WAIT(); asm volatile("" ::: "memory");
}
__device__ __forceinline__ void wconv_item8(const float* W, int K, int N, unsigned char* WT8, int row0, int n0, int k0, LAS float* scr, int lane, int row_mul = 1) {
    { f32x4 t[8];
#pragma unroll
      for (int i = 0; i < 8; ++i) t[i] = *(const f32x4*)(W + (size_t)(k0 + 8 * i + (lane >> 3)) * N + n0 + 4 * (lane & 7));
#pragma unroll
      for (int i = 0; i < 8; ++i) { LAS float* q = scr + (8 * i + (lane >> 3)) * 33 + 4 * (lane & 7); q[0] = t[i].x; q[1] = t[i].y; q[2] = t[i].z; q[3] = t[i].w; } }
    LDS_WAIT(); asm volatile("" ::: "memory");
    const int c = lane & 7;
#pragma unroll
    for (int j = 0; j < 4; ++j) { const int n = (lane >> 3) + 8 * j; const LAS float* s = scr + (8 * c) * 33 + n;
        u32x2 o; o.x = pk4_fp8(s[0 * 33] * 64.f, s[1 * 33] * 64.f, s[2 * 33] * 64.f, s[3 * 33] * 64.f); o.y = pk4_fp8(s[4 * 33] * 64.f, s[5 * 33] * 64.f, s[6 * 33] * 64.f, s[7 * 33] * 64.f);
        *(u32x2*)(WT8 + (size_t)(row0 + n * row_mul) * K + k0 + 8 * c) = o; }
    LDS_WAIT(); asm volatile("" ::: "memory");
}
__device__ __forceinline__ void phase_wconv(const Frame& F0, KArgs a0, int layer) {
    Frame F = F0; F.tid = fresh_tid(F0.wave); F.lane = F.tid & 63; F.wave = __builtin_amdgcn_readfirstlane(F.tid >> 6); const KArgs a = fresh_args(a0); unsigned char* const ws_ = a->ws; F.ctl = (unsigned*)(ws_ + WS_CTL);
    LAS float* scr = (LAS float*)(F.lds + F.wave * 16384);
    unsigned char* ws = ws_;
    bf16_t* win_t = (bf16_t*)(ws + WS_WIN); bf16_t* wbr_t = (bf16_t*)(ws + WS_WBR); bf16_t* wout_t = (bf16_t*)(ws + WS_WOUT);
    bf16_t* wgu_t = (bf16_t*)(ws + WS_WGU); bf16_t* wd_t = (bf16_t*)(ws + WS_WD);
    constexpr int I_IN = (D / 64) * (INC / 32), I_BR = (MIXW / 64) * (D / 32), I_OUT = (D / 64) * (D / 32), I_G = (D / 64) * (FF / 32), I_D = (FF / 64) * (D / 32);
    constexpr int NITEMS = I_IN + 3 * I_BR + I_OUT + 2 * NEXP * I_G + NEXP * I_D;
    const int gw = F.bid * NWAVES + F.wave, NGW = F.G * NWAVES;
    for (int it = gw; it < NITEMS; it += NGW) {
        int r = it;
        if (r < I_IN) {
            const int nblk = INC / 32, kb = r / nblk, nb = r % nblk, n0 = 32 * nb, seg = n0 >> 10;
            const float* W = a->w_in + (size_t)layer * D * INC;
            const int f8blk = seg <= 2 ? seg : (seg == 6 || seg == 7) ? seg - 3 : (seg >= 9 ? seg - 4 : -1);
            if (f8blk >= 0) wconv_item8(W, D, INC, (unsigned char*)(ws + WS_WIN8), f8blk * MIXW + (n0 & (MIXW - 1)), n0, 64 * kb, scr, F.lane);
            else wconv_item(W, D, INC, win_t, (seg == 8 ? 3 : seg - 3) * MIXW - n0 + (n0 & (MIXW - 1)), 1, scr, r, F.lane);
            continue; } r -= I_IN;
        if (r < 3 * I_BR) { const int g = r / I_BR; wconv_item(a->w_branch + (size_t)(layer * 3 + g) * MIXW * D, MIXW, D, wbr_t + (size_t)g * D * MIXW, 0, 1, scr, r % I_BR, F.lane); continue; } r -= 3 * I_BR;
        if (r < I_OUT) { wconv_item(a->w_out + (size_t)layer * D * D, D, D, wout_t, 0, 1, scr, r, F.lane); continue; } r -= I_OUT;
        if (r < NEXP * I_G) { const int e = r / I_G, it2 = r % I_G, nblk = FF / 32, kb = it2 / nblk, n0 = 32 * (it2 % nblk); wconv_item8(a->w_eg + (size_t)(layer * NEXP + e) * D * FF, D, FF, (unsigned char*)wgu_t + (size_t)e * 2 * FF * D, 2 * n0, n0, 64 * kb, scr, F.lane, 2); continue; } r -= NEXP * I_G;
        if (r < NEXP * I_G) { const int e = r / I_G, it2 = r % I_G, nblk = FF / 32, kb = it2 / nblk, n0 = 32 * (it2 % nblk); wconv_item8(a->w_eu + (size_t)(layer * NEXP + e) * D * FF, D, FF, (unsigned char*)wgu_t + (size_t)e * 2 * FF * D, 2 * n0 + 1, n0, 64 * kb, scr, F.lane, 2); continue; } r -= NEXP * I_G;
        { const int e = r / I_D, it2 = r % I_D, nblk = D / 32, kb = it2 / nblk, n0 = 32 * (it2 % nblk); wconv_item8(a->w_ed + (size_t)(layer * NEXP + e) * FF * D, FF, D, (unsigned char*)wd_t + (size_t)e * D * FF, n0, n0, 64 * kb, scr, F.lane); }
    }
}

__device__ __forceinline__ void rms_row_to_bf16(const f32x4 (&v)[8], const float* gain, bf16_t* orow, unsigned char* o8row, int lane) {
    f32x4 g[8];
#pragma unroll
    for (int j = 0; j < 8; ++j) g[j] = *((const f32x4*)gain + lane + 64 * j);
    float s = 0.f;
#pragma unroll
    for (int j = 0; j < 8; ++j) s += (v[j].x * v[j].x + v[j].y * v[j].y) + (v[j].z * v[j].z + v[j].w * v[j].w);
    const float rstd = 1.0f / sqrtf(wave_sum(s, lane) * (1.f / D) + RMS_EPS);
    u32x2* o8 = (u32x2*)orow + lane; unsigned* q8 = (unsigned*)o8row + lane;
#pragma unroll
    for (int j = 0; j < 8; ++j) { const f32x4 y = v[j] * rstd * g[j]; u32x2 o; o.x = pk2(y.x, y.y); o.y = pk2(y.z, y.w); o8[64 * j] = o;
        if (o8row) q8[64 * j] = pk4_fp8(y.x, y.y, y.z, y.w); }
}
__device__ __forceinline__ void phase_norm0(const Frame& F0, KArgs a0) {
    Frame F = F0; F.tid = fresh_tid(F0.wave); F.lane = F.tid & 63; F.wave = __builtin_amdgcn_readfirstlane(F.tid >> 6); const KArgs a = fresh_args(a0); unsigned char* const ws_ = a->ws; F.ctl = (unsigned*)(ws_ + WS_CTL);
    bf16_t* H = (bf16_t*)(ws_ + WS_H); unsigned char* H8 = ws_ + WS_H8; bf16_t* XB = (bf16_t*)(ws_ + WS_XB);
    const int gw = F.bid * NWAVES + F.wave, NGW = F.G * NWAVES;
    for (int m = gw; m < NTOK; m += 2 * NGW) {
        const int m2 = m + NGW;
        const f32x4* xr = (const f32x4*)(a->x + (size_t)m * D) + F.lane; const f32x4* xr2 = (const f32x4*)(a->x + (size_t)(m2 < NTOK ? m2 : m) * D) + F.lane; f32x4 v[8], v2[8];
#pragma unroll
        for (int j = 0; j < 8; ++j) { v[j] = xr[64 * j]; v2[j] = xr2[64 * j]; }
        { u32x2* xo = (u32x2*)(XB + (size_t)m * D) + F.lane; u32x2* xo2 = (u32x2*)(XB + (size_t)(m2 < NTOK ? m2 : m) * D) + F.lane;
#pragma unroll
          for (int j = 0; j < 8; ++j) { u32x2 o; o.x = pk2(v[j].x, v[j].y); o.y = pk2(v[j].z, v[j].w); xo[64 * j] = o; if (m2 < NTOK) { u32x2 o2; o2.x = pk2(v2[j].x, v2[j].y); o2.y = pk2(v2[j].z, v2[j].w); xo2[64 * j] = o2; } } }
        rms_row_to_bf16(v, a->attn_norm_g, H + (size_t)m * D, H8 + (size_t)m * D, F.lane);
        if (m2 < NTOK) rms_row_to_bf16(v2, a->attn_norm_g, H + (size_t)m2 * D, H8 + (size_t)m2 * D, F.lane);
    }
}
#define MFMA32(a, b, c) __builtin_amdgcn_mfma_f32_32x32x16_bf16((a), (b), (c), 0, 0, 0)
constexpr int KROW = 272, VROW = 136;
constexpr int AT_K0 = 0, AT_K1 = 64 * KROW, AT_V = 2 * 64 * KROW, AT_LX = AT_V + 64 * 576, AT_KM = AT_LX + 1024, AT_Q = ((AT_KM + 8 * 128 * 4 + 255) / 256) * 256, AT_END = AT_Q + 8 * 8 * 64 * 16;
constexpr int AT_WQ = MISC_OFF - 256, AT_SC = AT_WQ + 64;
static_assert(AT_END <= AT_WQ && AT_SC + 64 <= MISC_OFF, "attention LDS");

__device__ __forceinline__ float xhalf_sum(float x) { const auto rr = __builtin_amdgcn_permlane32_swap(__float_as_uint(x), __float_as_uint(x), false, false); return __uint_as_float(rr[0]) + __uint_as_float(rr[1]); }
__device__ __forceinline__ float xhalf_partner(float x, int hh) { const auto rr = __builtin_amdgcn_permlane32_swap(__float_as_uint(x), __float_as_uint(x), false, false); return __uint_as_float(hh ? rr[0] : rr[1]); }
__device__ __forceinline__ bf16x8 pack8(const f32x16& p, int s) {
    u32x4 w;
    if (s == 0) { w.x = pk2(p[0], p[1]); w.y = pk2(p[2], p[3]); w.z = pk2(p[4], p[5]); w.w = pk2(p[6], p[7]); }
    else        { w.x = pk2(p[8], p[9]); w.y = pk2(p[10], p[11]); w.z = pk2(p[12], p[13]); w.w = pk2(p[14], p[15]); }
    return __builtin_bit_cast(bf16x8, w);
}
__device__ __forceinline__ f32x16 zero16() { f32x16 z;
#pragma unroll
    for (int i = 0; i < 16; ++i) z[i] = 0.f;
    return z; }
template <bool LIM = false>
__device__ __forceinline__ f32x16 qk_block(const LAS unsigned char* Kl, int kb, int r, int hh, const bf16x8 (&qf)[8]) {
    f32x16 S = zero16();
    __builtin_amdgcn_s_setprio(1);
#pragma unroll
    for (int s = 0; s < 8; ++s) { const bf16x8 kf = *(const LAS bf16x8*)(Kl + (32 * kb + r) * KROW + (16 * s + 8 * hh) * 2); S = MFMA32(kf, qf[s], S);
        if (LIM && s == 3) __builtin_amdgcn_sched_barrier(0); }
    __builtin_amdgcn_s_setprio(0);
    return S;
}
template <bool LIM = false>
__device__ __forceinline__ void pv_block(const LAS unsigned char* Vl, int drow0, int kb, int r, int hh, const f32x16& p, f32x16 (&O)[4]) {
    const bf16x8 pk0 = pack8(p, 0), pk1 = pack8(p, 1);
#pragma unroll
    for (int db = 0; db < 4; ++db) {
#pragma unroll
        for (int s2 = 0; s2 < 2; ++s2) {
            const LAS unsigned char* ap = Vl + (drow0 + 32 * db + r) * VROW + (32 * kb + 16 * s2 + 4 * hh) * 2;
            const s16x4 lo = *(const LAS s16x4*)ap, hi = *(const LAS s16x4*)(ap + 16);
            const bf16x8 vf = __builtin_shufflevector(lo, hi, 0, 1, 2, 3, 4, 5, 6, 7);
            O[db] = MFMA32(vf, s2 ? pk1 : pk0, O[db]);
        }
        if (LIM && (db & 1)) __builtin_amdgcn_sched_barrier(0);
    }
}
typedef __amdgpu_buffer_rsrc_t rsrc_t;
__device__ __forceinline__ rsrc_t make_rsrc(const void* p, unsigned bytes) { return __builtin_amdgcn_make_buffer_rsrc((void*)p, 0, bytes, 0x00020000); }
__device__ __forceinline__ u32x4 bload16(rsrc_t rs, unsigned voff, unsigned soff) { return __builtin_bit_cast(u32x4, __builtin_amdgcn_raw_buffer_load_b128(rs, voff, soff, 0)); }
__device__ __forceinline__ void k_fetch(u32x4 (&pre)[2], rsrc_t rs, unsigned soff, int tid) {
#pragma unroll
    for (int i = 0; i < 2; ++i) { const unsigned c = (unsigned)tid + 512u * i, key = c >> 4, part = c & 15u; pre[i] = bload16(rs, key * (unsigned)(QP * 2) + part * 16u, soff); }
}
__device__ __forceinline__ void k_stash(const u32x4 (&pre)[2], LAS unsigned char* Kl, int tid) {
#pragma unroll
    for (int i = 0; i < 2; ++i) { const int c = tid + 512 * i, key = c >> 4, part = c & 15; *(LAS u32x4*)(Kl + key * KROW + part * 16) = pre[i]; }
}
template <int NCHK> __device__ __forceinline__ void v_fetch(u32x4 (&pre)[NCHK], rsrc_t rs, unsigned soff, int tid) {
#pragma unroll
    for (int i = 0; i < NCHK; ++i) { const unsigned c = (unsigned)tid + 512u * i, d = c >> 3, part = c & 7u; pre[i] = bload16(rs, d * (unsigned)(SEQ * 2) + part * 16u, soff); }
}
template <int NCHK> __device__ __forceinline__ void v_stash(const u32x4 (&pre)[NCHK], LAS unsigned char* Vl, int tid) {
#pragma unroll
    for (int i = 0; i < NCHK; ++i) { const int c = tid + 512 * i, d = c >> 3, part = c & 7; LAS u32x2* q = (LAS u32x2*)(Vl + d * VROW + part * 16);
        q[0] = (u32x2){pre[i].x, pre[i].y}; q[1] = (u32x2){pre[i].z, pre[i].w}; }
}
__device__ __forceinline__ void store_ot(const f32x16 (&O)[4], bf16_t* orow  , int hh, float sc) {
#pragma unroll
    for (int db = 0; db < 4; ++db)
#pragma unroll
        for (int g = 0; g < 4; ++g) { u32x2 o; o.x = pk2(O[db][4 * g] * sc, O[db][4 * g + 1] * sc); o.y = pk2(O[db][4 * g + 2] * sc, O[db][4 * g + 3] * sc);
            *(u32x2*)(orow + 32 * db + 8 * g + 4 * hh) = o; }
}

typedef short v4i16_t __attribute__((ext_vector_type(4)));
__device__ __forceinline__ s16x4 vtr(const LAS unsigned char* p) { return __builtin_bit_cast(s16x4, __builtin_amdgcn_ds_read_tr16_b64_v4i16((LAS v4i16_t*)p)); }
template <int NIMG> __device__ __forceinline__ void vrm_fetch(u32x4 (&pre)[2 * NIMG], rsrc_t rs, unsigned soff, int tid) {
#pragma unroll
    for (int i = 0; i < 2 * NIMG; ++i) { const unsigned c = (unsigned)tid + 512u * i, key = c / (16u * NIMG), cc = c % (16u * NIMG); pre[i] = bload16(rs, key * (unsigned)(QP * 2) + cc * 16u, soff); }
}
template <int NIMG> __device__ __forceinline__ void vrm_stash(const u32x4 (&pre)[2 * NIMG], LAS unsigned char* Vl, int tid) {
    constexpr unsigned VP = 256u * NIMG + 64u;
#pragma unroll
    for (int i = 0; i < 2 * NIMG; ++i) { const unsigned c = (unsigned)tid + 512u * i, key = c / (16u * NIMG), cc = c % (16u * NIMG); *(LAS u32x4*)(Vl + key * VP + cc * 16u) = pre[i]; }
}
template <int NIMG> __device__ __forceinline__ void pv_tr(const LAS unsigned char* Vl, int kb, int lane, const f32x16& p, f32x16 (&O)[4 * NIMG]) {
    constexpr unsigned VP = 256u * NIMG + 64u;
    const bf16x8 pk0 = pack8(p, 0), pk1 = pack8(p, 1);
    const unsigned hh = (unsigned)lane >> 5, blk = ((unsigned)lane >> 4) & 1u, q = ((unsigned)lane & 15u) >> 2, pp = (unsigned)lane & 3u;
    const LAS unsigned char* vb = Vl + (4u * hh + q) * VP + 32u * blk + 8u * pp;
    __builtin_amdgcn_s_setprio(1);
#pragma unroll
    for (int db = 0; db < 4 * NIMG; ++db) {
#pragma unroll
        for (int s2 = 0; s2 < 2; ++s2) {
            const s16x4 lo = vtr(vb + (32 * kb + 16 * s2) * VP + 64 * db), hi = vtr(vb + (32 * kb + 16 * s2 + 8) * VP + 64 * db);
            const bf16x8 vf = __builtin_shufflevector(lo, hi, 0, 1, 2, 3, 4, 5, 6, 7);
            O[db] = MFMA32(vf, s2 ? pk1 : pk0, O[db]);
        }
    }
    __builtin_amdgcn_s_setprio(0);
}

template <int MODE>
__device__ __forceinline__ void attn_unit_ac(LAS unsigned char* lds, int w, const bf16_t* Qp, const bf16_t* Kp, const bf16_t* Vp, bf16_t* Op, int q0, float slope2, const float* kmean_bh) {
    const int tid = fresh_tid(w); w = __builtin_amdgcn_readfirstlane(tid >> 6); const int lane = tid & 63, r = lane & 31, hh = lane >> 5;
    const int wq0 = q0 + 32 * w, tq = wq0 + r;
    LAS unsigned char* Kl = lds + AT_K0; LAS unsigned char* Vl = lds + AT_V;
    bf16x8 qf[8];
#pragma unroll
    for (int s = 0; s < 8; ++s) qf[s] = *(const bf16x8*)(Qp + (size_t)tq * QP + 16 * s + 8 * hh);
    const int own = q0 >> 8;
    unsigned selmask = 0u;
    if (MODE == 0) {
        LAS float* KM = (LAS float*)(lds + AT_KM);
        for (int idx = tid; idx < own * HD; idx += NTHR) KM[idx] = kmean_bh[idx];
        __syncthreads();
        float gsc[7];
#pragma unroll
        for (int n = 0; n < 7; ++n) {
            float acc = 0.f;
            if (n < own) {
#pragma unroll
                for (int s = 0; s < 8; ++s) { const f32x4 k0v = *(const LAS f32x4*)(KM + n * HD + 16 * s + 8 * hh), k1v = *(const LAS f32x4*)(KM + n * HD + 16 * s + 8 * hh + 4);
                    acc += bf2f((unsigned short)qf[s][0]) * k0v.x + bf2f((unsigned short)qf[s][1]) * k0v.y + bf2f((unsigned short)qf[s][2]) * k0v.z + bf2f((unsigned short)qf[s][3]) * k0v.w
                         + bf2f((unsigned short)qf[s][4]) * k1v.x + bf2f((unsigned short)qf[s][5]) * k1v.y + bf2f((unsigned short)qf[s][6]) * k1v.z + bf2f((unsigned short)qf[s][7]) * k1v.w; }
            }
            gsc[n] = xhalf_sum(acc);
        }
        if (own <= 3) selmask = (1u << own) - 1u;
        else {
#pragma unroll
            for (int pick = 0; pick < 3; ++pick) { float best = -__builtin_inff(); int bi = 0;
#pragma unroll
                for (int n = 0; n < 7; ++n) { const bool ok = (n < own) && !((selmask >> n) & 1u) && (gsc[n] > best); best = ok ? gsc[n] : best; bi = ok ? n : bi; }
                selmask |= 1u << bi; }
        }
    }
    f32x16 O[4];
#pragma unroll
    for (int db = 0; db < 4; ++db) O[db] = zero16();
    float lsum = 0.f, prun = 1.f;
    bool wdone = false;
    volatile LAS unsigned* dflag = (volatile LAS unsigned*)(lds + AT_SC + 32);
    if (MODE == 2 && lane == 0) dflag[w] = 0u;
    const int kt_hi = (q0 >> 6) + 3;
    const int dmax = (MODE == 0) ? (int)(160.0f / slope2) + 1 : (1 << 20);
    const int kt_lo = (q0 - dmax > 0) ? ((q0 - dmax) >> 6) : 0;
    u32x4 pk_[2], pv_[2];
    const rsrc_t rsK = make_rsrc(Kp, (unsigned)SEQ * QP * 2u), rsV = make_rsrc(Vp, (unsigned)SEQ * QP * 2u);
    k_fetch(pk_, rsK, (unsigned)(kt_hi * 64) * (unsigned)(QP * 2), tid); vrm_fetch<1>(pv_, rsV, (unsigned)(kt_hi * 64) * (unsigned)(QP * 2), tid);
    for (int kt = kt_hi; kt >= kt_lo; --kt) {
        k_stash(pk_, Kl, tid); vrm_stash<1>(pv_, Vl, tid);
        __syncthreads();
        if (kt > kt_lo) { k_fetch(pk_, rsK, (unsigned)((kt - 1) * 64) * (unsigned)(QP * 2), tid); vrm_fetch<1>(pv_, rsV, (unsigned)((kt - 1) * 64) * (unsigned)(QP * 2), tid); }
        const int k0 = kt * 64, kb256 = kt >> 2;
        const bool diag = (kb256 == own);
        bool active = (MODE == 0) ? (k0 <= wq0 + 31 && k0 + 63 >= wq0 - dmax) : (k0 < wq0 + 31 && !wdone);
        const bool sel = ((selmask >> kb256) & 1u) != 0u;
        if (MODE == 0 && !diag) active = active && (__any(sel ? 1 : 0) != 0);
        if (active) {
#pragma unroll
            for (int kbi = 0; kbi < 2; ++kbi) {
                const int kb = 1 - kbi;
                f32x16 S = qk_block(Kl, kb, r, hh, qf);
                const int kbase = k0 + 32 * kb + 4 * hh - tq;
                if (MODE == 0) {
                    const float base = slope2 * (float)kbase - ((const LAS float*)(lds + AT_SC))[0];
#pragma unroll
                    for (int i = 0; i < 16; ++i) { const int cI = (i & 3) + 8 * (i >> 2);
                        const float e = fast_exp2(S[i] + (base + slope2 * (float)cI));
                        const bool vis = diag ? (kbase + cI <= 0) : sel;
                        S[i] = vis ? e : 0.f; lsum += S[i]; }
                } else {
                    float sg[16], kp[16];
#pragma unroll
                    for (int i = 0; i < 16; ++i) { const int cI = (i & 3) + 8 * (i >> 2);
                        const float z = S[i] * QSCALE2;
                        const float en = fast_exp2(-fabsf(z)), rc = fast_rcp(1.0f + en), sm = en * rc;
                        const bool pos = z >= 0.f, vis = (kbase + cI < 0);
                        sg[i] = vis ? (pos ? rc : sm) : 0.f; kp[i] = vis ? (pos ? sm : rc) : 1.f; }
                    float G[4], Gp[4];
#pragma unroll
                    for (int g = 0; g < 4; ++g) { G[g] = (kp[4 * g] * kp[4 * g + 1]) * (kp[4 * g + 2] * kp[4 * g + 3]); Gp[g] = xhalf_partner(G[g], hh); }
                    float run = prun;
#pragma unroll
                    for (int g = 3; g >= 0; --g) {
                        float t = (hh == 0) ? run * Gp[g] : run;
                        S[4 * g + 3] = sg[4 * g + 3] * t; t *= kp[4 * g + 3];
                        S[4 * g + 2] = sg[4 * g + 2] * t; t *= kp[4 * g + 2];
                        S[4 * g + 1] = sg[4 * g + 1] * t; t *= kp[4 * g + 1];
                        S[4 * g + 0] = sg[4 * g + 0] * t;
                        run = run * (G[g] * Gp[g]);
                    }
                    prun = run;
                }
                pv_tr<1>(Vl, kb, lane, S, O);
            }
            if (MODE == 2) { wdone = __all(prun == 0.0f) != 0; if (wdone && lane == 0) dflag[w] = 1u; }
        }
        __syncthreads();
        if (MODE == 2) {
            const u32x4 f0 = *(const LAS u32x4*)(lds + AT_SC + 32), f1 = *(const LAS u32x4*)(lds + AT_SC + 48);
            if ((f0.x & f0.y & f0.z & f0.w & f1.x & f1.y & f1.z & f1.w) != 0u) break;
        }
    }
    float sc = 1.f;
    if (MODE == 0) { const float lt = xhalf_sum(lsum); sc = 1.0f / lt; }
    store_ot(O, Op + (size_t)tq * (3 * MIXW), hh, sc);
}

__device__ __forceinline__ void attn_unit_c(LAS unsigned char* lds, int w, const bf16_t* Qp, const bf16_t* Kp, const bf16_t* Vp, bf16_t* Op, int q0) {
    const int tid = fresh_tid(w); w = __builtin_amdgcn_readfirstlane(tid >> 6); const int lane = tid & 63, r = lane & 31, hh = lane >> 5;
    const int wq0 = q0 + 32 * w, tq = wq0 + r;
    LAS unsigned char* Vl = lds + w * (32 * 320);
    bf16x8 qf[8];
#pragma unroll
    for (int s = 0; s < 8; ++s) qf[s] = *(const bf16x8*)(Qp + (size_t)tq * QP + 16 * s + 8 * hh);
    const rsrc_t rsK = make_rsrc(Kp, (unsigned)SEQ * QP * 2u), rsV = make_rsrc(Vp, (unsigned)SEQ * QP * 2u);
    const unsigned kvo = (unsigned)r * (unsigned)(QP * 2) + 16u * hh;
    f32x16 O[4];
#pragma unroll
    for (int db = 0; db < 4; ++db) O[db] = zero16();
    float prun = 1.f;
    u32x4 kn[8], vn[8];
    int jb = wq0 >> 5;
    {
        const unsigned so = (unsigned)(jb * 32) * (unsigned)(QP * 2);
#pragma unroll
        for (int s = 0; s < 8; ++s) kn[s] = bload16(rsK, kvo + 32u * s, so);
#pragma unroll
        for (int i = 0; i < 8; ++i) { const unsigned c = (unsigned)lane + 64u * i; vn[i] = bload16(rsV, (c >> 4) * (unsigned)(QP * 2) + (c & 15u) * 16u, so); }
    }
    for (; jb >= 0; --jb) {
        u32x4 kc[8];
#pragma unroll
        for (int s = 0; s < 8; ++s) kc[s] = kn[s];
#pragma unroll
        for (int i = 0; i < 8; ++i) { const unsigned c = (unsigned)lane + 64u * i; *(LAS u32x4*)(Vl + (c >> 4) * 320u + (c & 15u) * 16u) = vn[i]; }
        if (jb > 0) {
            const unsigned so = (unsigned)((jb - 1) * 32) * (unsigned)(QP * 2);
#pragma unroll
            for (int s = 0; s < 8; ++s) kn[s] = bload16(rsK, kvo + 32u * s, so);
#pragma unroll
            for (int i = 0; i < 8; ++i) { const unsigned c = (unsigned)lane + 64u * i; vn[i] = bload16(rsV, (c >> 4) * (unsigned)(QP * 2) + (c & 15u) * 16u, so); }
        }
        f32x16 S = zero16();
#pragma unroll
        for (int s = 0; s < 8; ++s) S = MFMA32(__builtin_bit_cast(bf16x8, kc[s]), qf[s], S);
        const int kbase = jb * 32 + 4 * hh - tq;
        float sg[16], kp[16];
#pragma unroll
        for (int i = 0; i < 16; ++i) { const int cI = (i & 3) + 8 * (i >> 2);
            const float z = S[i] * QSCALE2;
            const float en = fast_exp2(-fabsf(z)), rc = fast_rcp(1.0f + en), sm = en * rc;
            const bool pos = z >= 0.f, vis = (kbase + cI < 0);
            sg[i] = vis ? (pos ? rc : sm) : 0.f; kp[i] = vis ? (pos ? sm : rc) : 1.f; }
        float G[4], Gp[4];
#pragma unroll
        for (int g = 0; g < 4; ++g) { G[g] = (kp[4 * g] * kp[4 * g + 1]) * (kp[4 * g + 2] * kp[4 * g + 3]); Gp[g] = xhalf_partner(G[g], hh); }
        float run = prun;
#pragma unroll
        for (int g = 3; g >= 0; --g) {
            float t = (hh == 0) ? run * Gp[g] : run;
            S[4 * g + 3] = sg[4 * g + 3] * t; t *= kp[4 * g + 3];
            S[4 * g + 2] = sg[4 * g + 2] * t; t *= kp[4 * g + 2];
            S[4 * g + 1] = sg[4 * g + 1] * t; t *= kp[4 * g + 1];
            S[4 * g + 0] = sg[4 * g + 0] * t;
            run = run * (G[g] * Gp[g]);
        }
        prun = run;
        {
            const bf16x8 pk0 = pack8(S, 0), pk1 = pack8(S, 1);
            const unsigned blk = ((unsigned)lane >> 4) & 1u, q = ((unsigned)lane & 15u) >> 2, pp = (unsigned)lane & 3u;
            const LAS unsigned char* vb = Vl + (4u * hh + q) * 320u + 32u * blk + 8u * pp;
#pragma unroll
            for (int db = 0; db < 4; ++db)
#pragma unroll
                for (int s2 = 0; s2 < 2; ++s2) { const s16x4 lo = vtr(vb + (16 * s2) * 320 + 64 * db), hi = vtr(vb + (16 * s2 + 8) * 320 + 64 * db);
                    O[db] = MFMA32(__builtin_shufflevector(lo, hi, 0, 1, 2, 3, 4, 5, 6, 7), s2 ? pk1 : pk0, O[db]); }
        }
        if (__all(prun == 0.0f)) break;
    }
    store_ot(O, Op + (size_t)tq * (3 * MIXW), hh, 1.0f);
}

template <int NDB>
__device__ __forceinline__ void pv_block_n(const LAS unsigned char* Vl, int kb, int r, int hh, const f32x16& p, f32x16 (&O)[NDB]) {
    const bf16x8 pk0 = pack8(p, 0), pk1 = pack8(p, 1);
#pragma unroll
    for (int db = 0; db < NDB; ++db) {
#pragma unroll
        for (int s2 = 0; s2 < 2; ++s2) {
            const LAS unsigned char* ap = Vl + (32 * db + r) * VROW + (32 * kb + 16 * s2 + 4 * hh) * 2;
            const s16x4 lo = *(const LAS s16x4*)ap, hi = *(const LAS s16x4*)(ap + 16);
            const bf16x8 vf = __builtin_shufflevector(lo, hi, 0, 1, 2, 3, 4, 5, 6, 7);
            O[db] = MFMA32(vf, s2 ? pk1 : pk0, O[db]);
        }
    }
}
__device__ __forceinline__ void attn_unit_b(LAS unsigned char* lds, int w, const bf16_t* Qp, const bf16_t* Kp, const bf16_t* Vp, bf16_t* Op, int q0, float slope2, const float* hgain) {
    const int tid = fresh_tid(w); w = __builtin_amdgcn_readfirstlane(tid >> 6); const int lane = tid & 63, r = lane & 31, hh = lane >> 5;
    const int qsub = w & 3, dh = w >> 2;
    const int wq0 = q0 + 32 * qsub, tq = wq0 + r;
    LAS unsigned char* Kl0 = lds + AT_K0; LAS unsigned char* Kl1 = lds + AT_K1; LAS unsigned char* Vl = lds + AT_V;
    const LAS unsigned char* Kmine = dh ? Kl1 : Kl0;
    LAS unsigned char* Ql = lds + AT_Q + (w * 8 * 64 + lane) * 16;
    {
        bf16x8 qf[8];
#pragma unroll
        for (int s = 0; s < 8; ++s) qf[s] = *(const bf16x8*)(Qp + (size_t)tq * QP + dh * HD + 16 * s + 8 * hh);
#pragma unroll
        for (int s = 0; s < 8; ++s) *(LAS bf16x8*)(Ql + s * 1024) = qf[s];
    }
    const int kt_hi = (q0 >> 6) + 1;
    const int dmax = (int)(160.0f / slope2) + 1;
    const int kt_lo = (q0 - dmax > 0) ? ((q0 - dmax) >> 6) : 0;
    float lsum = 0.f;
    f32x16 O[8];
#pragma unroll
    for (int db = 0; db < 8; ++db) O[db] = zero16();
    {
        u32x4 pa[2], pb[2], pv_[4];
        const rsrc_t rsK = make_rsrc(Kp, (unsigned)SEQ * QP * 2u), rsV = make_rsrc(Vp, (unsigned)SEQ * QP * 2u);
        k_fetch(pa, rsK, (unsigned)(kt_hi * 64) * (unsigned)(QP * 2), tid); k_fetch(pb, rsK, (unsigned)(kt_hi * 64) * (unsigned)(QP * 2) + HD * 2u, tid); vrm_fetch<2>(pv_, rsV, (unsigned)(kt_hi * 64) * (unsigned)(QP * 2), tid);
        for (int kt = kt_hi; kt >= kt_lo; --kt) {
            k_stash(pa, Kl0, tid); k_stash(pb, Kl1, tid); vrm_stash<2>(pv_, Vl, tid);
            __syncthreads();
            if (kt > kt_lo) { k_fetch(pa, rsK, (unsigned)((kt - 1) * 64) * (unsigned)(QP * 2), tid); k_fetch(pb, rsK, (unsigned)((kt - 1) * 64) * (unsigned)(QP * 2) + HD * 2u, tid); vrm_fetch<2>(pv_, rsV, (unsigned)((kt - 1) * 64) * (unsigned)(QP * 2), tid); }
            const int k0 = kt * 64;
            if (k0 <= wq0 + 31 && k0 + 63 >= wq0 - dmax) {
#pragma unroll
                for (int kb = 0; kb < 2; ++kb) {
                    const int kbase = k0 + 32 * kb + 4 * hh - tq; const float base = slope2 * (float)kbase - ((const LAS float*)(lds + AT_SC))[1];
                    f32x16 S = zero16();
#pragma unroll
                    for (int s = 0; s < 8; ++s) { const bf16x8 kf = *(const LAS bf16x8*)(Kmine + (32 * kb + r) * KROW + (16 * s + 8 * hh) * 2); const bf16x8 qv = *(const LAS bf16x8*)(Ql + s * 1024); S = MFMA32(kf, qv, S); }
#pragma unroll
                    for (int i = 0; i < 16; ++i) { const int cI = (i & 3) + 8 * (i >> 2); const float e = fast_exp2(S[i] + (base + slope2 * (float)cI)); S[i] = (kbase + cI <= 0) ? e : 0.f; lsum += S[i]; }
                    pv_tr<2>(Vl, kb, lane, S, O);
                }
            }
            __syncthreads();
        }
    }
    {
        const float lam = ((volatile LAS float*)(lds + AT_SC))[2]; const float lt = xhalf_sum(lsum); const float sc = (dh ? -lam : 1.0f) / lt;
        const int lane = fresh_tid(w) & 63;
        LAS float* XL = (LAS float*)lds;
#pragma unroll
        for (int db = 0; db < 4; ++db)
#pragma unroll
            for (int i = 0; i < 16; ++i) { const float give = dh ? O[db][i] : O[db + 4][i]; XL[((w * 4 + db) * 16 + i) * 64 + lane] = give * sc; }
        __syncthreads();
        const int pw = w ^ 4;
#pragma unroll
        for (int db = 0; db < 4; ++db)
#pragma unroll
            for (int i = 0; i < 16; ++i) { const float mine = dh ? O[db + 4][i] : O[db][i]; O[db][i] = mine * sc + XL[((pw * 4 + db) * 16 + i) * 64 + lane]; }
        __syncthreads();
    }
    float ss = 0.f;
#pragma unroll
    for (int db = 0; db < 4; ++db)
#pragma unroll
        for (int i = 0; i < 16; ++i) ss += O[db][i] * O[db][i];
    ss = xhalf_sum(ss);
    const int tz = fresh_tid(w);
    const int lane2 = tz & 63, r2 = lane2 & 31, hh2 = lane2 >> 5, w2 = tz >> 6, qs2 = w2 & 3, dh2 = w2 >> 2;
    LAS float* LX = (LAS float*)(lds + AT_LX);
    if (hh2 == 0) LX[dh2 * 128 + 32 * qs2 + r2] = ss;
    __syncthreads();
    const float tot = LX[32 * qs2 + r2] + LX[128 + 32 * qs2 + r2];
    const float rstd = ((volatile LAS float*)(lds + AT_SC))[3] / sqrtf(tot * (1.f / 256.f) + RMS_EPS);
    bf16_t* orow = Op + (size_t)(q0 + 32 * qs2 + r2) * (3 * MIXW) + 128 * dh2;
#pragma unroll
    for (int db = 0; db < 4; ++db)
#pragma unroll
        for (int g = 0; g < 4; ++g) { const int d = 32 * db + 8 * g + 4 * hh2; const f32x4 hg = *(const f32x4*)(hgain + 128 * dh2 + d);
            u32x2 o; o.x = pk2(O[db][4 * g] * rstd * hg.x, O[db][4 * g + 1] * rstd * hg.y); o.y = pk2(O[db][4 * g + 2] * rstd * hg.z, O[db][4 * g + 3] * rstd * hg.w);
            *(u32x2*)(orow + d) = o; }
    __syncthreads();
}

__device__ __forceinline__ int wq_pop(unsigned* ctr, LAS unsigned char* lds, int wave) {
    volatile LAS unsigned* slot = (volatile LAS unsigned*)(lds + AT_WQ);
    __syncthreads();
    if (is_thread0(wave)) slot[0] = __hip_atomic_fetch_add(ctr, 1u, __ATOMIC_RELAXED, __HIP_MEMORY_SCOPE_AGENT);
    __syncthreads();
    return (int)__builtin_amdgcn_readfirstlane(slot[0]);
}
__device__ __forceinline__ void phase_attn(const Frame& F0, KArgs a0, int layer_in, int chunk) {
    int layer = layer_in; asm volatile("" : "+s"(layer));
    Frame F = F0; F.tid = fresh_tid(F0.wave); F.lane = F.tid & 63; F.wave = __builtin_amdgcn_readfirstlane(F.tid >> 6); const KArgs a = fresh_args(a0); unsigned char* const ws_ = a->ws; F.ctl = (unsigned*)(ws_ + WS_CTL);
    const bf16_t* PROJ = (const bf16_t*)(ws_ + WS_PROJ); bf16_t* BR = (bf16_t*)(ws_ + WS_BR) + (size_t)chunk * CHT * (3 * MIXW); const float* KMEAN = (const float*)(ws_ + WS_KMEAN);
    unsigned* wq = F.ctl + CW_WQ + ((layer * NCH + chunk) * 3) * 64;
    float gqa = fmaxf(fabsf(a->moba_q_gain[layer * HD + F.lane]), fabsf(a->moba_q_gain[layer * HD + 64 + F.lane]));
    float gka = fmaxf(fabsf(a->moba_k_gain[layer * HD + F.lane]), fabsf(a->moba_k_gain[layer * HD + 64 + F.lane]));
    float gqb = fmaxf(fabsf(a->diff_q_gain[layer * HD + F.lane]), fabsf(a->diff_q_gain[layer * HD + 64 + F.lane]));
    float gkb = fmaxf(fabsf(a->diff_k_gain[layer * HD + F.lane]), fabsf(a->diff_k_gain[layer * HD + 64 + F.lane]));
    {
        const float m2a_ = 128.f * QSCALE2 * wave_max(gqa, F.lane) * wave_max(gka, F.lane), m2b_ = 128.f * QSCALE2 * wave_max(gqb, F.lane) * wave_max(gkb, F.lane);
        const float s1 = wave_sum(a->lq1[layer * HD + F.lane] * a->lk1[layer * HD + F.lane] + a->lq1[layer * HD + 64 + F.lane] * a->lk1[layer * HD + 64 + F.lane], F.lane);
        const float s2 = wave_sum(a->lq2[layer * HD + F.lane] * a->lk2[layer * HD + F.lane] + a->lq2[layer * HD + 64 + F.lane] * a->lk2[layer * HD + 64 + F.lane], F.lane);
        const float lam_init = layer == 0 ? 0.2f : 0.35550906759096926f;
        static_assert(DEPTH == 2, "lam_init table");
        volatile LAS float* sc = (volatile LAS float*)(F.lds + AT_SC);
        __syncthreads();
        if (F.tid == 0) { sc[0] = m2a_; sc[1] = m2b_; sc[2] = expf(s1) - expf(s2) + lam_init; sc[3] = 1.0f - lam_init; }
        __syncthreads();
    }
    SUBP_BEGIN(5)
    for (;;) {
        const int u = wq_pop(wq + 0 * 64, F.lds, F.wave); if (u >= 16 * CHB * 4) break;
        const int qb = 15 - (u >> 5), b = (u & 31) >> 2, hb = u & 3;
        const float slope2 = exp2f(-2.0f * (float)(hb + 1)) * 1.4426950408889634f;
        const bf16_t* base = PROJ + (size_t)b * SEQ * QP;
        attn_unit_b(F.lds, F.wave, base + 3072 + hb * 256, base + 4096 + hb * 256, base + 5120 + hb * 256, BR + (size_t)b * SEQ * (3 * MIXW) + MIXW + hb * 256,
                    qb * 128, slope2, a->diff_head_gain + layer * 256);
    }
    SUBP_END(5)
    SUBP_BEGIN(6)
    for (;;) {
        const int u = wq_pop(wq + 1 * 64, F.lds, F.wave); if (u >= 8 * CHB * 8) break;
        const int qb = 7 - (u >> 6), b = (u & 63) >> 3, h = u & 7;
        const float slope2 = exp2f(-(float)(h + 1)) * 1.4426950408889634f;
        const bf16_t* base = PROJ + (size_t)b * SEQ * QP;
        attn_unit_ac<0>(F.lds, F.wave, base + h * HD, base + 1024 + h * HD, base + 2048 + h * HD, BR + (size_t)b * SEQ * (3 * MIXW) + h * HD,
                        qb * 256, slope2, KMEAN + ((size_t)b * 8 + h) * 8 * HD);
    }
    SUBP_END(6)
    SUBP_BEGIN(7)
    for (;;) {
        const int u = wq_pop(wq + 2 * 64, F.lds, F.wave); if (u >= 8 * CHB * 8) break;
        const int qb = 7 - (u >> 6), b = (u & 63) >> 3, h = u & 7;
        const bf16_t* base = PROJ + (size_t)b * SEQ * QP;
        attn_unit_c(F.lds, F.wave, base + 6144 + h * HD, base + 7168 + h * HD, base + 8192 + h * HD, BR + (size_t)b * SEQ * (3 * MIXW) + 2 * MIXW + h * HD, qb * 256);
    }
    SUBP_END(7)
}
template <int N> __device__ __forceinline__ void halve_step(float (&v)[N], int m, int lane) {
    const bool up = (lane & m) != 0;
#pragma unroll
    for (int i = 0; i < N / 2; ++i) { const float lo = v[i], hi = v[i + N / 2]; const float keep = up ? hi : lo, send = up ? lo : hi; v[i] = keep + shx(send, m, lane); }
}
__device__ __forceinline__ void phase_router(const Frame& F0, KArgs a0, int layer) {
    Frame F = F0; F.tid = fresh_tid(F0.wave); F.lane = F.tid & 63; F.wave = __builtin_amdgcn_readfirstlane(F.tid >> 6); const KArgs a = fresh_args(a0); unsigned char* const ws_ = a->ws; F.ctl = (unsigned*)(ws_ + WS_CTL);
    unsigned char* H8 = ws_ + WS_H8;
    int* tok_e = (int*)(ws_ + WS_ROUT + RO_E); float* tok_w = (float*)(ws_ + WS_ROUT + RO_W);
    const float* gain = a->ffn_norm_g + layer * D; const float* wrg = a->w_rg + (size_t)layer * D * 4; const float* wre = a->w_re + (size_t)layer * D * NEXP;
    const bf16_t* xin = (const bf16_t*)(ws_ + WS_XB);
    constexpr int RT = 16, XP = 2 * D + 16, XBUF = RT * XP;
    constexpr int PA = 2 * XBUF, PB = 147456, PW = RT * 36 * 4;
    static_assert(PA + 4 * PW + 128 + 256 + 2048 <= 146432 - 256 && PB + 4 * PW <= LDS_BYTES, "router LDS");
    LAS unsigned char* lds = F.lds;
    LAS float* rs = (LAS float*)(lds + PA + 4 * PW);
    LAS int* myE = (LAS int*)(lds + PA + 4 * PW + 128 + 128);
    LAS float* mypart = (LAS float*)(lds + (F.wave < 4 ? PA + F.wave * PW : PB + (F.wave - 4) * PW));
    const int kq = F.lane >> 4, r16 = F.lane & 15;
    constexpr int NT = NTOK / RT;
    bf16x8 Bh[8][2], Bl[8][2];
#pragma unroll
    for (int s = 0; s < 8; ++s)
#pragma unroll
        for (int nb = 0; nb < 2; ++nb) {
            const int col = 16 * nb + r16; const int k0 = 256 * F.wave + 32 * s + 8 * kq;
            float wv[8];
#pragma unroll
            for (int e = 0; e < 8; ++e) { const int k = k0 + e; wv[e] = wre[(size_t)k * NEXP + col] * gain[k]; }
            u32x4 hw, lw;
#pragma unroll
            for (int e2 = 0; e2 < 4; ++e2) { const unsigned h = pk2(wv[2 * e2], wv[2 * e2 + 1]); hw[e2] = h; lw[e2] = pk2(wv[2 * e2] - bflo(h), wv[2 * e2 + 1] - bfhi(h)); }
            Bh[s][nb] = __builtin_bit_cast(bf16x8, hw); Bl[s][nb] = __builtin_bit_cast(bf16x8, lw);
        }
    __builtin_amdgcn_sched_barrier(0);
    auto dma_rows = [&](int tile_, int buf_) {
#pragma unroll
        for (int i = 0; i < 2; ++i) { const int r = 2 * F.wave + i; const bf16_t* src = xin + (size_t)(tile_ * RT + r) * D + F.lane * 8; LAS unsigned char* dst = lds + buf_ * XBUF + r * XP;
#pragma unroll
            for (int c = 0; c < 4; ++c) __builtin_amdgcn_global_load_lds((const unsigned*)(src + c * 512), (LAS unsigned*)(dst + c * 1024), 16, 0, 0); } };
    auto norm_rows = [&](int tile_, int buf_) {
        int ln = F.lane; asm volatile("" : "+v"(ln));
        const LAS u32x2* hr0 = (const LAS u32x2*)(lds + buf_ * XBUF + (2 * F.wave) * XP) + ln; const LAS u32x2* hr1 = (const LAS u32x2*)(lds + buf_ * XBUF + (2 * F.wave + 1) * XP) + ln;
        float s0 = 0.f, s1 = 0.f;
#pragma unroll
        for (int j = 0; j < 8; ++j) { const u32x2 t = hr0[64 * j], u = hr1[64 * j];
            { const float x0 = bflo(t.x), x1 = bfhi(t.x), x2 = bflo(t.y), x3 = bfhi(t.y); s0 += (x0 * x0 + x1 * x1) + (x2 * x2 + x3 * x3); }
            { const float x0 = bflo(u.x), x1 = bfhi(u.x), x2 = bflo(u.y), x3 = bfhi(u.y); s1 += (x0 * x0 + x1 * x1) + (x2 * x2 + x3 * x3); } }
        const float rstd0 = 1.0f / sqrtf(wave_sum(s0, ln) * (1.f / D) + RMS_EPS), rstd1 = 1.0f / sqrtf(wave_sum(s1, ln) * (1.f / D) + RMS_EPS);
        if (ln == 0) { rs[buf_ * RT + 2 * F.wave] = rstd0; rs[buf_ * RT + 2 * F.wave + 1] = rstd1; }
        unsigned* o80 = (unsigned*)(H8 + (size_t)(tile_ * RT + 2 * F.wave) * D) + ln; unsigned* o81 = o80 + D / 4;
#pragma unroll
        for (int hf = 0; hf < 2; ++hf) {
            f32x4 g[4];
#pragma unroll
            for (int j = 0; j < 4; ++j) g[j] = *((const f32x4*)gain + ln + 64 * (4 * hf + j));
#pragma unroll
            for (int j = 0; j < 4; ++j) { const u32x2 t = hr0[64 * (4 * hf + j)], u = hr1[64 * (4 * hf + j)];
                const f32x4 y0 = (f32x4){bflo(t.x), bfhi(t.x), bflo(t.y), bfhi(t.y)} * rstd0 * g[j], y1 = (f32x4){bflo(u.x), bfhi(u.x), bflo(u.y), bfhi(u.y)} * rstd1 * g[j];
                o80[64 * (4 * hf + j)] = pk4_fp8(y0.x, y0.y, y0.z, y0.w); o81[64 * (4 * hf + j)] = pk4_fp8(y1.x, y1.y, y1.z, y1.w); }
        } };
    int tile = F.bid;
    if (tile < NT) {
        dma_rows(tile, 0);
        if (tile + F.G < NT) { dma_rows(tile + F.G, 1); asm volatile("s_waitcnt vmcnt(8)" ::: "memory"); } else asm volatile("s_waitcnt vmcnt(0)" ::: "memory");
        norm_rows(tile, 0);
    }
    __syncthreads();
    f32x4 WG[4];
    { int lz = F.lane; asm volatile("" : "+v"(lz));
#pragma unroll
      for (int s = 0; s < 4; ++s) { const int k = 256 * F.wave + 64 * s + lz; WG[s] = *(const f32x4*)(wrg + (size_t)k * 4) * gain[k]; } }
    int buf = 0, it = 0;
    for (; tile < NT; tile += F.G, buf ^= 1, ++it) {
        {
            f32x4 acc[2];
#pragma unroll
            for (int nb = 0; nb < 2; ++nb) acc[nb] = (f32x4){0.f, 0.f, 0.f, 0.f};
            const LAS unsigned char* ap = lds + buf * XBUF + r16 * XP + (256 * F.wave + 8 * kq) * 2;
#pragma unroll
            for (int s = 0; s < 8; ++s) { const bf16x8 av = *(const LAS bf16x8*)(ap + s * 64);
#pragma unroll
                for (int nb = 0; nb < 2; ++nb) { acc[nb] = __builtin_amdgcn_mfma_f32_16x16x32_bf16(av, Bh[s][nb], acc[nb], 0, 0, 0); acc[nb] = __builtin_amdgcn_mfma_f32_16x16x32_bf16(av, Bl[s][nb], acc[nb], 0, 0, 0); } }
#pragma unroll
            for (int nb = 0; nb < 2; ++nb)
#pragma unroll
                for (int e = 0; e < 4; ++e) mypart[(4 * kq + e) * 36 + 4 + 16 * nb + r16] = acc[nb][e];
#pragma unroll
            for (int hv = 0; hv < 2; ++hv) {
                float gv[32];
#pragma unroll
                for (int i = 0; i < 32; ++i) gv[i] = 0.f;
                const LAS unsigned short* xp = (const LAS unsigned short*)(lds + buf * XBUF + (8 * hv) * XP) + 256 * F.wave + F.lane;
#pragma unroll
                for (int s = 0; s < 4; ++s) { const f32x4 wv = WG[s];
#pragma unroll
                    for (int t = 0; t < 8; ++t) { const float h = __uint_as_float((unsigned)xp[t * (XP / 2) + 64 * s] << 16); gv[4 * t] += h * wv.x; gv[4 * t + 1] += h * wv.y; gv[4 * t + 2] += h * wv.z; gv[4 * t + 3] += h * wv.w; } }
                halve_step<32>(gv, 32, F.lane); { float (&v16)[16] = *(float (*)[16])gv; halve_step<16>(v16, 16, F.lane); float (&v8)[8] = *(float (*)[8])gv; halve_step<8>(v8, 8, F.lane);
                    float (&v4)[4] = *(float (*)[4])gv; halve_step<4>(v4, 4, F.lane); float (&v2)[2] = *(float (*)[2])gv; halve_step<2>(v2, 2, F.lane); }
                { const float tot = gv[0] + shx(gv[0], 1, F.lane);
                  if ((F.lane & 1) == 0) mypart[(8 * hv + (F.lane >> 3)) * 36 + ((F.lane >> 1) & 3)] = tot; }
            }
        }
        if (tile + F.G < NT) { asm volatile("s_waitcnt vmcnt(0)" ::: "memory"); norm_rows(tile + F.G, buf ^ 1); }
        __syncthreads();
        if (tile + 2 * F.G < NT) dma_rows(tile + 2 * F.G, buf);
#pragma unroll
        for (int tt = 0; tt < 2; ++tt) {
            const int tok = 2 * F.wave + tt;
            float s = 0.f;
            if (F.lane < 36) {
#pragma unroll
                for (int w = 0; w < 8; ++w) s += *(const LAS float*)(lds + (w < 4 ? PA + w * PW : PB + (w - 4) * PW) + (tok * 36 + F.lane) * 4);
            }
            s *= rs[buf * RT + tok];
            const int si = __float_as_int(s);
            const float l0 = __int_as_float(__builtin_amdgcn_readlane(si, 0)), l1 = __int_as_float(__builtin_amdgcn_readlane(si, 1)), l2 = __int_as_float(__builtin_amdgcn_readlane(si, 2)), l3 = __int_as_float(__builtin_amdgcn_readlane(si, 3));
            int gi = 0; float gm = l0;
            if (l1 > gm) { gm = l1; gi = 1; }
            if (l2 > gm) { gm = l2; gi = 2; }
            if (l3 > gm) { gm = l3; gi = 3; }
            const float gz = ((expf(l0 - gm) + expf(l1 - gm)) + expf(l2 - gm)) + expf(l3 - gm);
            const float gtop = 1.0f / gz;
            const int eb = 4 + 8 * gi;
            float es[8];
#pragma unroll
            for (int q = 0; q < 8; ++q) es[q] = __int_as_float(__builtin_amdgcn_readlane(si, eb + q));
            int i0 = 0; float m0 = es[0];
#pragma unroll
            for (int q = 1; q < 8; ++q) { if (es[q] > m0) { m0 = es[q]; i0 = q; } }
            int i1 = -1; float m1 = -__builtin_inff();
#pragma unroll
            for (int q = 0; q < 8; ++q) { if (q != i0 && es[q] > m1) { m1 = es[q]; i1 = q; } }
            const float p1 = expf(m1 - m0);
            const float w0 = gtop / (1.0f + p1), w1 = gtop * p1 / (1.0f + p1);
            if (F.lane == 0) { const int m = tile * RT + tok; tok_e[2 * m] = gi * 8 + i0; tok_e[2 * m + 1] = gi * 8 + i1; tok_w[2 * m] = w0; tok_w[2 * m + 1] = w1;
                myE[it * 32 + 2 * tok] = gi * 8 + i0; myE[it * 32 + 2 * tok + 1] = gi * 8 + i1; }
        }
        __syncthreads();
    }
    asm volatile("s_waitcnt vmcnt(0)" ::: "memory");
    __syncthreads();
    {
        int* a_pos = (int*)(ws_ + WS_ROUT + RO_POS); unsigned* cnt = F.ctl + CW_CNT + layer * NEXP * 64;
        LAS unsigned* hist = (LAS unsigned*)F.lds; LAS unsigned* basev = hist + 32;
        const int nas = it * 32;
        for (int base = 0; base < nas; base += 256) {
            if (F.tid < 32) hist[F.tid] = 0u;
            __syncthreads();
            const int i = base + F.tid; const bool act = F.tid < 256 && i < nas;
            int e = 0; unsigned rank = 0u;
            if (act) { e = myE[i]; rank = __hip_atomic_fetch_add(hist + e, 1u, __ATOMIC_RELAXED, __HIP_MEMORY_SCOPE_WORKGROUP); }
            __syncthreads();
            if (F.tid < 32) { const unsigned h = hist[F.tid]; basev[F.tid] = h ? __hip_atomic_fetch_add(cnt + F.tid * 64, h, __ATOMIC_RELAXED, __HIP_MEMORY_SCOPE_AGENT) : 0u; }
            __syncthreads();
            if (act) { const int m = (F.bid + (i >> 5) * F.G) * RT + ((i & 31) >> 1); a_pos[2 * m + (i & 1)] = (int)(basev[e] + rank); }
            __syncthreads();
        }
    }
}
__device__ __forceinline__ void phase_scatter(const Frame& F0, KArgs a0, int layer) {
    Frame F = F0; F.tid = fresh_tid(F0.wave); F.lane = F.tid & 63; F.wave = __builtin_amdgcn_readfirstlane(F.tid >> 6); const KArgs a = fresh_args(a0); unsigned char* const ws_ = a->ws; F.ctl = (unsigned*)(ws_ + WS_CTL);
    const int* tok_e = (const int*)(ws_ + WS_ROUT + RO_E); const int* a_pos = (const int*)(ws_ + WS_ROUT + RO_POS); int* a_slot = (int*)(ws_ + WS_ROUT + RO_SLOT);
    int* tile_expert = (int*)(ws_ + WS_ROUT + RO_TILE); int* arow = (int*)(ws_ + WS_ROUT + RO_MAP);
    unsigned* cnt = F.ctl + CW_CNT + layer * NEXP * 64;
    LAS int* pstart = (LAS int*)F.lds; LAS int* pend = pstart + 32; LAS int* pcnt = pstart + 64;
    if (F.tid < NEXP) pcnt[F.tid] = (int)__hip_atomic_load(cnt + F.tid * 64, __ATOMIC_RELAXED, __HIP_MEMORY_SCOPE_AGENT);
    __syncthreads();
    if (F.tid == 0) { int run = 0;
        for (int e = 0; e < NEXP; ++e) { const int c = pcnt[e]; pstart[e] = run; run += ((c + 255) >> 8) << 8; pend[e] = run; } }
    __syncthreads();
    if (F.bid == 0 && F.tid <= MAXTILES) {
        const int ntiles = pend[NEXP - 1] >> 8;
        if (F.tid == MAXTILES) tile_expert[MAXTILES] = ntiles;
        else { int e = 0; for (int q = 0; q < NEXP; ++q) e += (pend[q] <= F.tid * 256) ? 1 : 0; tile_expert[F.tid] = e < NEXP ? e : NEXP - 1; }
    }
    if (F.bid < NEXP) {
        for (int s = pstart[F.bid] + pcnt[F.bid] + F.tid; s < pend[F.bid]; s += NTHR) arow[s] = 0;
    }
    for (int as = F.bid * NTHR + F.tid; as < NASSIGN; as += F.G * NTHR) {
        const int e = tok_e[as], slot = pstart[e] + a_pos[as];
        a_slot[as] = slot; arow[slot] = as >> 1;
    }
    __syncthreads();
}
__device__ __forceinline__ void phase_combine(const Frame& F0, KArgs a0, int layer) {
    Frame F = F0; F.tid = fresh_tid(F0.wave); F.lane = F.tid & 63; F.wave = __builtin_amdgcn_readfirstlane(F.tid >> 6); const KArgs a = fresh_args(a0); unsigned char* const ws_ = a->ws; F.ctl = (unsigned*)(ws_ + WS_CTL);
    const int* a_slot = (const int*)(ws_ + WS_ROUT + RO_SLOT); const float* tok_w = (const float*)(ws_ + WS_ROUT + RO_W);
    const bf16_t* Y = (const bf16_t*)(ws_ + WS_Y); bf16_t* H = (bf16_t*)(ws_ + WS_H); bf16_t* XB = (bf16_t*)(ws_ + WS_XB);
    const int gw = F.bid * NWAVES + F.wave, NGW = F.G * NWAVES;
    for (int mb = gw; mb < NTOK; mb += 2 * NGW) {
        f32x4 v[2][8];
#pragma unroll
        for (int q = 0; q < 2; ++q) { const int m = (mb + q * NGW < NTOK) ? mb + q * NGW : mb;
            const int s0 = a_slot[2 * m], s1 = a_slot[2 * m + 1]; const float w0 = tok_w[2 * m], w1 = tok_w[2 * m + 1];
            const u32x2* xr = (const u32x2*)(XB + (size_t)m * D) + F.lane;
            const u32x2* y0 = (const u32x2*)(Y + (size_t)s0 * D) + F.lane; const u32x2* y1 = (const u32x2*)(Y + (size_t)s1 * D) + F.lane;
#pragma unroll
            for (int j = 0; j < 8; ++j) { const u32x2 xw_ = xr[64 * j]; const f32x4 x = {bflo(xw_.x), bfhi(xw_.x), bflo(xw_.y), bfhi(xw_.y)}; const u32x2 p = y0[64 * j], r = y1[64 * j];
                f32x4 c; c.x = w0 * bflo(p.x) + w1 * bflo(r.x); c.y = w0 * bfhi(p.x) + w1 * bfhi(r.x); c.z = w0 * bflo(p.y) + w1 * bflo(r.y); c.w = w0 * bfhi(p.y) + w1 * bfhi(r.y);
                v[q][j] = x + c; } }
#pragma unroll
        for (int q = 0; q < 2; ++q) { const int m = mb + q * NGW; if (m < NTOK) {
            if (layer + 1 < DEPTH) {
                u32x2* xw = (u32x2*)(XB + (size_t)m * D) + F.lane;
#pragma unroll
                for (int j = 0; j < 8; ++j) { u32x2 o; o.x = pk2(v[q][j].x, v[q][j].y); o.y = pk2(v[q][j].z, v[q][j].w); xw[64 * j] = o; }
                rms_row_to_bf16(v[q], a->attn_norm_g + (layer + 1) * D, H + (size_t)m * D, ws_ + WS_H8 + (size_t)m * D, F.lane);
            } else {
                f32x4* xw = (f32x4*)(a->out + (size_t)m * D) + F.lane;
#pragma unroll
                for (int j = 0; j < 8; ++j) xw[64 * j] = v[q][j];
            } } }
    }
}

constexpr int NSTEPS = 1 + DEPTH * (NCH * 2 + 2 + 5);
__global__ void __launch_bounds__(NTHR, 2) mega_fwd(Args a_unused) {
    const KArgs a = (KArgs)__builtin_amdgcn_kernarg_segment_ptr();
    extern __shared__ __attribute__((aligned(16))) unsigned char lds_raw[];
    Frame F;
    F.lds = (LAS unsigned char*)lds_raw; F.MISC = (volatile LAS unsigned*)(F.lds + MISC_OFF);
    F.wave = __builtin_amdgcn_readfirstlane((int)threadIdx.x >> 6); F.tid = fresh_tid(F.wave); F.lane = F.tid & 63; F.G = gridDim.x; F.bid = blockIdx.x;
    F.ctl = (unsigned*)(a->ws + WS_CTL);
    for (int u = F.tid; u < 256; u += NTHR) ((LAS unsigned*)(F.lds + MISC_OFF))[u] = 0u;
    __syncthreads();
    const int lo = a->step_lo, hi = a->step_hi;
    XcdBarrier bar; bar.bar = F.ctl + CW_BAR; bar.x = 0; bar.st = nullptr; bar.wave = F.wave;
    if (hi - lo > 1) bar = xcd_barrier_post(F.ctl + CW_BAR, F.MISC + 8, F.wave);
    int step = 0;
#ifdef PROBE_MASK
    unsigned long long tacc = 0ull, tph = 0ull;
#define PHASE_BEGIN if (step >= lo && step < hi) { tph = __builtin_amdgcn_s_memrealtime();
#ifndef PROBE_BAR
#define PROBE_BAR 0
#endif
#define PHASE_END(cat)   { const unsigned long long tb_ = __builtin_amdgcn_s_memrealtime(); if (step + 1 < hi) xcd_barrier(bar); const unsigned long long te_ = __builtin_amdgcn_s_memrealtime(); if ((PROBE_MASK >> (cat)) & 1) tacc += te_ - tph; if ((PROBE_BAR >> (cat)) & 1) tacc += te_ - tb_; } } ++step;
#else
#define PHASE_BEGIN if (step >= lo && step < hi) {
#define PHASE_END(cat)   if (step + 1 < hi) xcd_barrier(bar); } ++step;
#endif

    PHASE_BEGIN phase_norm0(F, a); phase_wconv(F, a, 0); __syncthreads(); PHASE_END(0)

    for (int layer = 0; layer < DEPTH; ++layer) {
        for (int chunk = 0; chunk < NCH; ++chunk) {
            PHASE_BEGIN {
                unsigned char* const ws = fresh_args(a)->ws; bf16_t* H = (bf16_t*)(ws + WS_H); bf16_t* PROJ = (bf16_t*)(ws + WS_PROJ); const bf16_t* win_t = (const bf16_t*)(ws + WS_WIN);
                const KArgs ka = fresh_args(a);
                const size_t gofs = (WS_GATES - WS_PROJ) + (size_t)chunk * CHT * GP;
                { pg8::Gemm g{H + (size_t)chunk * CHT * D, win_t, D, D, D, 0}; pg8::StaticOrder S; int bid_ = F.bid, G_ = F.G; asm volatile("" : "+s"(bid_), "+s"(G_)); S.init(CHT, 4 * MIXW, G_, bid_);
                  pg8::EpiProj E{PROJ, ka->gate_bias + (size_t)layer * 3 * D, ka->moba_q_gain + layer * HD, ka->moba_k_gain + layer * HD, ka->diff_q_gain + layer * HD, ka->diff_k_gain + layer * HD, (float*)(ws + WS_KMEAN), F.lds + XTRA_OFF, 0x8543ull, gofs};
                  pg8::gemm_phase<pg8::EpiProj, pg8::StaticOrder, true>(F.lds, g, S, E, F.wave); }
                {
                  pg8::Gemm g{(const bf16_t*)(ws + WS_H8 + (size_t)chunk * CHT * D), (const bf16_t*)(ws + WS_WIN8), D / 2, D / 2, D / 2, 0}; pg8::StaticOrder S; int bid_ = F.bid, G_ = F.G; asm volatile("" : "+s"(bid_), "+s"(G_)); S.init(CHT, 11 * MIXW, G_, bid_);
                  pg8::EpiProj E{PROJ, ka->gate_bias + (size_t)layer * 3 * D, ka->moba_q_gain + layer * HD, ka->moba_k_gain + layer * HD, ka->diff_q_gain + layer * HD, ka->diff_k_gain + layer * HD, (float*)(ws + WS_KMEAN), F.lds + XTRA_OFF, 0xEDCBA976210ull, gofs};
                  pg8::gemm_phase<pg8::EpiProj, pg8::StaticOrder, true, true>(F.lds, g, S, E, F.wave); }
            } PHASE_END(1)
            PHASE_BEGIN phase_attn(F, a, layer, chunk); PHASE_END(3)
        }
        {
            PHASE_BEGIN {
                unsigned char* const ws = fresh_args(a)->ws; const unsigned char* GATES = ws + WS_GATES; bf16_t* BR = (bf16_t*)(ws + WS_BR); bf16_t* MIXB = (bf16_t*)(ws + WS_MIXB); const bf16_t* wbr_t = (const bf16_t*)(ws + WS_WBR);
                pg8::Gemm g{BR, wbr_t, 3 * MIXW, MIXW, MIXW, (size_t)D * MIXW, (size_t)MIXW}; pg8::ChainOrder S; int bid_ = F.bid, G_ = F.G; asm volatile("" : "+s"(bid_), "+s"(G_)); S.init(NTOK, D, G_, bid_); S.nb = 3;
                pg8::EpiGateChain E{GATES, MIXB};
                pg8::gemm_phase<pg8::EpiGateChain, pg8::ChainOrder, true>(F.lds, g, S, E, F.wave);
            } PHASE_END(4)
            PHASE_BEGIN {
                unsigned char* const ws = fresh_args(a)->ws; bf16_t* MIXB = (bf16_t*)(ws + WS_MIXB); const bf16_t* wout_t = (const bf16_t*)(ws + WS_WOUT);
                pg8::Gemm g{MIXB, wout_t, D, D, D, 0}; pg8::StaticOrder S; int bid_ = F.bid, G_ = F.G; asm volatile("" : "+s"(bid_), "+s"(G_)); S.init(NTOK, D, G_, bid_);
                pg8::EpiResid E{(bf16_t*)(ws + WS_XB)};
                pg8::gemm_phase<pg8::EpiResid, pg8::StaticOrder, true>(F.lds, g, S, E, F.wave);
            } PHASE_END(5)
        }
        PHASE_BEGIN phase_router(F, a, layer); PHASE_END(6)
        PHASE_BEGIN phase_scatter(F, a, layer); PHASE_END(8)
        PHASE_BEGIN {
            unsigned char* const ws = fresh_args(a)->ws; unsigned char* ACT = ws + WS_ACT; const bf16_t* wgu_t = (const bf16_t*)(ws + WS_WGU); const int* tile_expert = (const int*)(ws + WS_ROUT + RO_TILE);
            const int ntiles = __builtin_amdgcn_readfirstlane(tile_expert[MAXTILES]);
            pg8::Gemm g{(const bf16_t*)(ws + WS_H8), wgu_t, D / 2, D / 2, D / 2, (size_t)2 * FF * D / 2, 0, (const int*)(ws + WS_ROUT + RO_MAP)}; pg8::MoeOrder S; int bid_ = F.bid, G_ = F.G; asm volatile("" : "+s"(bid_), "+s"(G_)); S.init(ntiles * 256, 2 * FF, G_, bid_); S.tile_expert = tile_expert;
            pg8::EpiSwiglu E{ACT};
            pg8::gemm_phase<pg8::EpiSwiglu, pg8::MoeOrder, true, true, true>(F.lds, g, S, E, F.wave);
        } PHASE_END(9)
        PHASE_BEGIN {
            unsigned char* const ws = fresh_args(a)->ws; const bf16_t* ACT = (const bf16_t*)(ws + WS_ACT); bf16_t* Y = (bf16_t*)(ws + WS_Y); const bf16_t* wd_t = (const bf16_t*)(ws + WS_WD); const int* tile_expert = (const int*)(ws + WS_ROUT + RO_TILE);
            const int ntiles = __builtin_amdgcn_readfirstlane(tile_expert[MAXTILES]);
            pg8::Gemm g{ACT, wd_t, FF / 2, FF / 2, FF / 2, (size_t)D * FF / 2};     pg8::MoeOrder S; int bid_ = F.bid, G_ = F.G; asm volatile("" : "+s"(bid_), "+s"(G_)); S.init(ntiles * 256, D, G_, bid_); S.tile_expert = tile_expert;
            pg8::EpiBf16Plain E{Y, D};
            pg8::gemm_phase<pg8::EpiBf16Plain, pg8::MoeOrder, true, true, false, 0x00007b79>(F.lds, g, S, E, F.wave);
        } PHASE_END(10)
        PHASE_BEGIN phase_combine(F, a, layer); if (layer + 1 < DEPTH) { phase_wconv(F, a, layer + 1); __syncthreads(); } PHASE_END(11)
    }
#ifdef PROBE_MASK
    if (blockIdx.x == 0 && is_thread0(F.wave)) { const unsigned long long t0 = __builtin_amdgcn_s_memrealtime(); unsigned long long tt = tacc;
#if defined(PROBE_SUB) || defined(PROBE_EPI)
        tt += F.MISC[16];
#endif
        while (__builtin_amdgcn_s_memrealtime() - t0 < tt) __builtin_amdgcn_s_sleep(16); }
#endif
#undef PHASE_BEGIN
#undef PHASE_END
}

extern "C" void kernel_launch(void* const* d_in, const int* in_sizes, int n_in, void* d_out, int out_size, void* d_ws, size_t ws_size, hipStream_t stream) {
    static int grid = 0;
    if (grid == 0) {
        if (n_in != 21 || in_sizes[0] != NTOK * D || out_size != NTOK * D || ws_size < WS_END) { fprintf(stderr, "kernel_launch: unexpected shapes (n_in %d, in0 %d, out %d, ws %zu); nothing launched\n", n_in, n_in > 0 ? in_sizes[0] : -1, out_size, ws_size); grid = -1; return; }
        int dev = 0, cus = 0, per_cu = 0;
        if (hipGetDevice(&dev) != hipSuccess || hipDeviceGetAttribute(&cus, hipDeviceAttributeMultiprocessorCount, dev) != hipSuccess) { grid = -1; return; }
        if (hipFuncSetAttribute((const void*)mega_fwd, hipFuncAttributeMaxDynamicSharedMemorySize, LDS_BYTES) != hipSuccess) { fprintf(stderr, "kernel_launch: hipFuncSetAttribute failed\n"); grid = -1; return; }
        if (hipOccupancyMaxActiveBlocksPerMultiprocessor(&per_cu, (const void*)mega_fwd, NTHR, LDS_BYTES) != hipSuccess || per_cu < 1) fprintf(stderr, "kernel_launch: occupancy query reports %d blocks per CU\n", per_cu);
        (void)hipGetLastError();
        grid = cus;
        if (grid < 128 || grid > 1024) { fprintf(stderr, "kernel_launch: unexpected CU count %d; nothing launched\n", grid); grid = -1; return; }
    }
    if (grid < 0) return;
    (void)hipMemsetAsync((char*)d_ws + WS_CTL, 0, (size_t)32 * MiB, stream);
    Args a{};
    a.x = (const float*)d_in[0]; a.attn_norm_g = (const float*)d_in[1]; a.w_in = (const float*)d_in[2]; a.gate_bias = (const float*)d_in[3];
    a.moba_q_gain = (const float*)d_in[4]; a.moba_k_gain = (const float*)d_in[5]; a.diff_q_gain = (const float*)d_in[6]; a.diff_k_gain = (const float*)d_in[7];
    a.lq1 = (const float*)d_in[8]; a.lk1 = (const float*)d_in[9]; a.lq2 = (const float*)d_in[10]; a.lk2 = (const float*)d_in[11]; a.diff_head_gain = (const float*)d_in[12];
    a.w_branch = (const float*)d_in[13]; a.w_out = (const float*)d_in[14]; a.ffn_norm_g = (const float*)d_in[15]; a.w_rg = (const float*)d_in[16]; a.w_re = (const float*)d_in[17];
    a.w_eg = (const float*)d_in[18]; a.w_eu = (const float*)d_in[19]; a.w_ed = (const float*)d_in[20];
    a.out = (float*)d_out; a.ws = (unsigned char*)d_ws;
#ifndef MK_SPLIT
    a.step_lo = 0; a.step_hi = NSTEPS;
    hipLaunchKernelGGL(mega_fwd, dim3(grid), dim3(NTHR), LDS_BYTES, stream, a);
#else
    for (int s = 0; s < NSTEPS; ++s) { a.step_lo = s; a.step_hi = s + 1; hipLaunchKernelGGL(mega_fwd, dim3(grid), dim3(NTHR), LDS_BYTES, stream, a); }
#endif
}
```

```cpp
#include <hip/hip_runtime.h>
#include <cstdio>
#include <cstdint>

#define LAS __attribute__((address_space(3)))
typedef unsigned short bf16_t;
typedef short bf16x8 __attribute__((ext_vector_type(8)));
typedef short s16x4 __attribute__((ext_vector_type(4)));
typedef float f32x4 __attribute__((ext_vector_type(4)));
typedef float f32x2 __attribute__((ext_vector_type(2)));
typedef float f32x16 __attribute__((ext_vector_type(16)));
typedef unsigned u32x4 __attribute__((ext_vector_type(4)));
typedef unsigned u32x2 __attribute__((ext_vector_type(2)));
typedef __bf16 bf16x2_t __attribute__((ext_vector_type(2)));
typedef int v8i32 __attribute__((ext_vector_type(8)));
typedef int v4i32 __attribute__((ext_vector_type(4)));

constexpr int D = 2048, BATCH = 16, SEQ = 2048, DEPTH = 2, NTOK = BATCH * SEQ;
constexpr int HD = 128, MIXW = 1024, INC = 9 * MIXW + 3 * D;
constexpr int QP = 9 * MIXW, GP = 3 * D;
constexpr int NEXP = 32, FF = 512, NASSIGN = NTOK * 2;
constexpr int CHB = 8, CHT = CHB * SEQ, NCH = BATCH / CHB;
constexpr int MAXTILES = NASSIGN / 256 + NEXP, MAXSLOTS = MAXTILES * 256;
constexpr float RMS_EPS = 1e-6f;
constexpr float QSCALE2 = 0.08838834764831845f * 1.4426950408889634f;

constexpr size_t MiB = 1u << 20;
constexpr size_t WS_CTL = 0, CTL_BYTES = 4 * MiB;
constexpr size_t WS_WIN = 4 * MiB, WS_WBR = 64 * MiB, WS_WOUT = 76 * MiB, WS_WGU = 84 * MiB, WS_WD = 212 * MiB;
constexpr size_t WS_H = 276 * MiB;
constexpr size_t WS_R = 404 * MiB;
constexpr size_t WS_PROJ = WS_R, WS_GATES = WS_R + 288 * MiB, WS_BR = WS_R + 672 * MiB, WS_MIXB = WS_R, WS_KMEAN = WS_R + 864 * MiB;
constexpr size_t WS_ACT = WS_R + 288 * MiB, WS_Y = WS_R, WS_ROUT = WS_R + 330 * MiB;
constexpr size_t WS_XB = WS_R + 480 * MiB;
constexpr size_t WS_WIN8 = 148 * MiB;
constexpr size_t WS_RSTD = WS_H;
constexpr size_t WS_H8 = WS_R + 866 * MiB;
constexpr size_t WS_END = WS_H8 + 64 * MiB;
constexpr size_t RO_E = 0, RO_W = 1 * MiB, RO_POS = 2 * MiB, RO_SLOT = 3 * MiB, RO_TILE = 4 * MiB, RO_MAP = 4 * MiB + 65536;
constexpr int CW_BAR = 0;
constexpr int CW_WQ = 4096;
constexpr int CW_CNT = 8192;
constexpr int CW_FLAG = 16384;

__device__ __forceinline__ unsigned pk2(float lo, float hi) { f32x2 v = {lo, hi}; bf16x2_t b = __builtin_convertvector(v, bf16x2_t); return __builtin_bit_cast(unsigned, b); }
__device__ __forceinline__ unsigned pk4_fp8(float a, float b, float c, float d) { int r = 0; r = __builtin_amdgcn_cvt_pk_fp8_f32(a, b, r, false); r = __builtin_amdgcn_cvt_pk_fp8_f32(c, d, r, true); return (unsigned)r; }
__device__ __forceinline__ float bf2f(unsigned short b) { return __uint_as_float(((unsigned)b) << 16); }
__device__ __forceinline__ float bflo(unsigned w) { return __uint_as_float(w << 16); }
__device__ __forceinline__ float bfhi(unsigned w) { return __uint_as_float(w & 0xffff0000u); }
__device__ __forceinline__ float shx(float v, int m, int lane) { return __int_as_float(__builtin_amdgcn_ds_bpermute((lane ^ m) << 2, __float_as_int(v))); }
__device__ __forceinline__ int shl_i(int v, int src_lane) { return __builtin_amdgcn_ds_bpermute(src_lane << 2, v); }
__device__ __forceinline__ float wave_sum(float v, int lane) {
#pragma unroll
    for (int o = 1; o < 64; o <<= 1) v += shx(v, o, lane);
    return v;
}
__device__ __forceinline__ float wave_max(float v, int lane) {
#pragma unroll
    for (int o = 1; o < 64; o <<= 1) v = fmaxf(v, shx(v, o, lane));
    return v;
}
__device__ __forceinline__ float fast_exp2(float x) { return __builtin_amdgcn_exp2f(x); }
__device__ __forceinline__ float fast_rcp(float x) { return __builtin_amdgcn_rcpf(x); }
__device__ __forceinline__ unsigned pk4_u8(float a, float b, float c, float d) { unsigned r = 0u;
    r = __builtin_amdgcn_cvt_pk_u8_f32(a * 256.f - 0.5f, 0u, r); r = __builtin_amdgcn_cvt_pk_u8_f32(b * 256.f - 0.5f, 1u, r); r = __builtin_amdgcn_cvt_pk_u8_f32(c * 256.f - 0.5f, 2u, r); r = __builtin_amdgcn_cvt_pk_u8_f32(d * 256.f - 0.5f, 3u, r); return r; }
__device__ __forceinline__ float u8h(unsigned w, int i) { return (float)((w >> (8 * i)) & 255u) + 0.5f; }
__device__ __forceinline__ float sigmoidf_(float x) { return fast_rcp(1.0f + fast_exp2(-1.4426950408889634f * x)); }
__device__ __forceinline__ int lane_id_() { int t; asm volatile("v_mbcnt_lo_u32_b32 %0, -1, 0\n\tv_mbcnt_hi_u32_b32 %0, -1, %0" : "=v"(t)); return t; }
__device__ __forceinline__ bool is_thread0(int wave) { return wave == 0 && lane_id_() == 0; }
__device__ __forceinline__ int fresh_tid(int wave) { int t = lane_id_() + 64 * wave; asm volatile("" : "+v"(t)); return t; }
template <class T> __device__ __forceinline__ T* fresh_ptr(T* p) { asm volatile("" : "+s"(p)); return p; }
__device__ __forceinline__ float uniformf(float v) { return __uint_as_float(__builtin_amdgcn_readfirstlane(__float_as_uint(v))); }
#define LDS_WAIT() asm volatile("s_waitcnt lgkmcnt(0)" ::: "memory")
#define VM_WAIT() asm volatile("s_waitcnt vmcnt(0)" ::: "memory")

#define XB_TMO      128
#define XB_XCNT(j)  (256  + 64 * (j))
#define XB_XSUB(j)  (1280 + 64 * (j))
#define XB_XGEN(j)  (2304 + 64 * (j))
#define XB_TOP      3328
#define XB_TOPGEN   3392
#define XCD_BAR_WORDS 3456
#define XB_SPIN_CAP (1u << 24)
__device__ __forceinline__ unsigned xb_ld(unsigned* p)              { return __hip_atomic_load(p, __ATOMIC_RELAXED, __HIP_MEMORY_SCOPE_AGENT); }
__device__ __forceinline__ unsigned xb_add(unsigned* p, unsigned v) { return __hip_atomic_fetch_add(p, v, __ATOMIC_RELAXED, __HIP_MEMORY_SCOPE_AGENT); }
__device__ __forceinline__ unsigned xb_xcc_id() { return (unsigned)__builtin_amdgcn_s_getreg((3 << 11) | 20) & 0xFu; }
#define XB_SPIN(cond, bar) do { unsigned _sp = 0; while (cond) { __builtin_amdgcn_s_sleep(1); \
    if ((++_sp & 255u) == 0u) { if (xb_ld(&(bar)[XB_TMO])) break; if (_sp > XB_SPIN_CAP) { atomicAdd(&(bar)[XB_TMO], 1u); break; } } } } while (0)
struct XcdBarrier { unsigned* bar; unsigned x; volatile LAS unsigned* st; int wave; };
__device__ __forceinline__ XcdBarrier xcd_barrier_post(unsigned* bar, volatile LAS unsigned* st, int wave) {
    XcdBarrier b; b.bar = bar; b.x = xb_xcc_id(); b.st = st; b.wave = wave;
    if (is_thread0(wave)) (void)xb_add(&bar[XB_XCNT(b.x)], 1u);
    return b;
}
__device__ __forceinline__ void xcd_barrier_complete(unsigned* bar, unsigned x, unsigned& nloc, unsigned& nx) {
    const unsigned G = gridDim.x * gridDim.y * gridDim.z;
    unsigned sum, cnt, mine, sp = 0u;
    for (;;) {
        sum = 0u; cnt = 0u; mine = 0u;
#pragma unroll
        for (unsigned j = 0; j < 16; ++j) { const unsigned c = xb_ld(&bar[XB_XCNT(j)]); sum += c; cnt += (c > 0u) ? 1u : 0u; mine = (j == x) ? c : mine; }
        if (sum == G) break;
        __builtin_amdgcn_s_sleep(1);
        if ((++sp & 255u) == 0u) { if (xb_ld(&bar[XB_TMO])) break; if (sp > XB_SPIN_CAP) { atomicAdd(&bar[XB_TMO], 1u); break; } }
    }
    nloc = mine > 0u ? mine : 1u; nx = cnt > 0u ? cnt : 1u;
}
__device__ __forceinline__ void xcd_barrier(const XcdBarrier& b) {
    asm volatile("s_waitcnt vmcnt(0)" ::: "memory");
    __syncthreads();
    if (is_thread0(b.wave)) {
        unsigned* bar = b.bar;
        __builtin_amdgcn_s_waitcnt(0);
        unsigned nloc = b.st[0], nx = b.st[1];
        if (nloc == 0u) { xcd_barrier_complete(bar, b.x, nloc, nx); b.st[0] = nloc; b.st[1] = nx; }
        const unsigned old = xb_add(&bar[XB_XSUB(b.x)], 1u);
        const unsigned gen = old / nloc;
        if (old + 1u == (gen + 1u) * nloc) {
            __builtin_amdgcn_fence(__ATOMIC_RELEASE, "agent");
            asm volatile("s_waitcnt vmcnt(0)" ::: "memory");
            const unsigned og = xb_add(&bar[XB_TOP], 1u);
            const unsigned tg = og / nx;
            if (og + 1u == (tg + 1u) * nx) xb_add(&bar[XB_TOPGEN], 1u);
            else XB_SPIN(xb_ld(&bar[XB_TOPGEN]) == tg, bar);
            __builtin_amdgcn_fence(__ATOMIC_ACQUIRE, "agent");
            xb_add(&bar[XB_XGEN(b.x)], 1u);
            asm volatile("s_waitcnt vmcnt(0)" ::: "memory");
        } else {
            XB_SPIN(xb_ld(&bar[XB_XGEN(b.x)]) == gen, bar);
            __builtin_amdgcn_fence(__ATOMIC_ACQUIRE, "agent");
            asm volatile("s_waitcnt vmcnt(0)" ::: "memory");
        }
    }
    __syncthreads();
}

namespace pg8 {
constexpr int BM = 256, BK = 64, HALF = 128, HTB = HALF * BK * 2, STAGE_BYTES = 8 * HTB, NXCD = 8, WGM = 8;
__host__ __device__ __forceinline__ int lds_byte(int r, int c) { const int st = (r >> 4) * 2 + (c >> 5), rr = r & 15, cc = c & 31, ob = rr * 64 + cc * 2; return st * 1024 + (ob ^ (((ob >> 9) & 1) << 5)); }
__host__ __device__ __forceinline__ void stage_rc(int b, int& R, int& C) { const int st = b / 1024, sb = b % 1024, swz = sb ^ (((sb >> 9) & 1) << 5); R = (st >> 1) * 16 + swz / 64; C = (st & 1) * 32 + (swz % 64) / 2; }
__host__ __device__ __forceinline__ int perm32(int rho) { const int n = rho >> 4, i = rho & 15; return 8 * (i >> 2) + 4 * n + (i & 3); }

struct Unit { int pm, pn, be; };
struct Gemm { const bf16_t* A; const bf16_t* Bt; int lda, ldb, K; size_t bstride; size_t astride = 0; const int* arow = nullptr; };

struct StaticOrder {
    int nM, nN, nwg, G, c;
    __device__ void init(int M, int N, int G_, int c_) { nM = M / BM; nN = N / BM; nwg = nM * nN; G = G_; c = c_; }
    __device__ bool next(int i, Unit& u) const {
        const long L = (long)i * G + c; if (L >= nwg) return false;
        int wgid = (int)L; { const int q = nwg / NXCD, r = nwg % NXCD, xcd = wgid % NXCD, off = wgid / NXCD; wgid = (xcd < r ? xcd * (q + 1) : r * (q + 1) + (xcd - r) * q) + off; }
        const int nig = WGM * nN, gid = wgid / nig, fm = gid * WGM, gsz = (nM - fm) < WGM ? (nM - fm) : WGM;
        u.pm = fm + ((wgid % nig) % gsz); u.pn = (wgid % nig) / gsz; u.be = 0; return true;
    }
};
struct BatchOrder : StaticOrder {
    int nb;
    __device__ bool next(int i, Unit& u) const {
        const long L = (long)i * G + c; if (L >= (long)nb * nwg) return false;
        const int b = (int)(L / nwg), l = (int)(L - (long)b * nwg);
        StaticOrder S1 = *this; S1.c = l % G; if (!S1.StaticOrder::next(l / G, u)) return false;
        u.be = b; return true;
    }
};
struct ChainOrder : StaticOrder {
    int nb;
    __device__ bool next(int i, Unit& u) const { const int j = i / nb, b = i - j * nb; if (!StaticOrder::next(j, u)) return false; u.be = b; return true; }
};
struct MoeOrder : StaticOrder {
    const int* tile_expert;
    __device__ bool next(int i, Unit& u) const {
        if (!StaticOrder::next(i, u)) return false;
        u.be = __builtin_amdgcn_readfirstlane(tile_expert[u.pm]); return true;
    }
};

template <class Epi, class Sched, bool ALIGN_EPI, bool FP8 = false, bool GATHER = false, int SC8 = 0x00007f79>
__device__ __forceinline__ void gemm_phase(LAS unsigned char* lds, const Gemm g, const Sched& S, const Epi& E, int wave_) {
    const int tid = fresh_tid(wave_), wid = __builtin_amdgcn_readfirstlane(tid >> 6), lane = tid & 63, wr = wid >> 2, wc = wid & 3, fr = lane & 15, fq = lane >> 4;
    const int K = g.K, nt = K / BK;
    unsigned voffA[2], voffB[2]; int rowA[2]; unsigned colA[2];
#pragma unroll
    for (int i = 0; i < 2; ++i) { int R, C; stage_rc(tid * 16 + i * 8192, R, C); const int Rb = Epi::PERM ? ((R & ~31) + perm32(R & 31)) : R;
        voffA[i] = (unsigned)(R * g.lda + C) * 2u; voffB[i] = (unsigned)(Rb * g.ldb + C) * 2u; rowA[i] = R; colA[i] = (unsigned)C * 2u; }
    unsigned gA0[2], gA1[2], nG0[2], nG1[2];
    auto gather_offs = [&](int pm, unsigned (&o0)[2], unsigned (&o1)[2]) {
#pragma unroll
        for (int i = 0; i < 2; ++i) { const int r0 = g.arow[pm * BM + rowA[i]], r1 = g.arow[pm * BM + HALF + rowA[i]];
            o0[i] = (unsigned)(r0 < 0 ? 0 : r0) * (unsigned)(g.lda * 2) + colA[i]; o1[i] = (unsigned)(r1 < 0 ? 0 : r1) * (unsigned)(g.lda * 2) + colA[i]; } };
    const size_t kstep = (size_t)(BK * 2);
    const size_t hsA = (size_t)HALF * g.lda * 2, hsB = (size_t)HALF * g.ldb * 2;
    const unsigned ldsw = (unsigned)wid * 1024u;
    const int aoff = lds_byte(wr * 64 + fr, fq * 8), boff = lds_byte(wc * 32 + fr, fq * 8);
#define PG8_SA(b, h) (((b) * 2 + (h)) * HTB)
#define PG8_SB(b, h) ((4 + (b) * 2 + (h)) * HTB)
#define PG8_STAGE(bufoff, gbase, voff) do { _Pragma("unroll") for (int _i = 0; _i < 2; ++_i) \
        __builtin_amdgcn_global_load_lds((const unsigned*)((const char*)(gbase) + (voff)[_i]), (LAS unsigned*)(lds + (bufoff) + ldsw + _i * 8192), 16, 0, 0); } while (0)
#define PG8_STA(bufoff, h, ptr, nx) do { if constexpr (GATHER) { unsigned vo_[2]; _Pragma("unroll") for (int _j = 0; _j < 2; ++_j) vo_[_j] = (nx) ? ((h) ? nG1[_j] : nG0[_j]) : ((h) ? gA1[_j] : gA0[_j]); PG8_STAGE(bufoff, ptr, vo_); } \
        else PG8_STAGE(bufoff, (ptr) + (h) * hsA, voffA); } while (0)
#define PG8_LDA(dst, b, h) do { _Pragma("unroll") for (int m = 0; m < 4; ++m) { if constexpr (FP8) { const v4i32 f0_ = *(const LAS v4i32*)(lds + PG8_SA(b, h) + aoff + m * 2048), f1_ = *(const LAS v4i32*)(lds + PG8_SA(b, h) + aoff + m * 2048 + 1024); \
            dst##8[m] = __builtin_shufflevector(f0_, f1_, 0, 1, 2, 3, 4, 5, 6, 7); } else { _Pragma("unroll") for (int k = 0; k < 2; ++k) dst[m][k] = *(const LAS bf16x8*)(lds + PG8_SA(b, h) + aoff + m * 2048 + k * 1024); } } } while (0)
#define PG8_LDB(dst, b, h) do { _Pragma("unroll") for (int n = 0; n < 2; ++n) { if constexpr (FP8) { const v4i32 f0_ = *(const LAS v4i32*)(lds + PG8_SB(b, h) + boff + n * 2048), f1_ = *(const LAS v4i32*)(lds + PG8_SB(b, h) + boff + n * 2048 + 1024); \
            dst##8[n] = __builtin_shufflevector(f0_, f1_, 0, 1, 2, 3, 4, 5, 6, 7); } else { _Pragma("unroll") for (int k = 0; k < 2; ++k) dst[n][k] = *(const LAS bf16x8*)(lds + PG8_SB(b, h) + boff + n * 2048 + k * 1024); } } } while (0)
#define PG8_MMA(ai, bj, At, Bt) do { __builtin_amdgcn_s_setprio(1); _Pragma("unroll") for (int m = 0; m < 4; ++m) _Pragma("unroll") for (int n = 0; n < 2; ++n) { \
        if constexpr (FP8) asm volatile("v_mfma_scale_f32_16x16x128_f8f6f4 %0, %1, %2, %0, %3, %3 op_sel:[0,1,0] op_sel_hi:[0,0,0]" : "+v"(acc[ai][bj][m][n]) : "v"(Bt##8[n]), "v"(At##8[m]), "v"(sc8_)); \
        else { _Pragma("unroll") for (int k = 0; k < 2; ++k) acc[ai][bj][m][n] = __builtin_amdgcn_mfma_f32_16x16x32_bf16(Bt[n][k], At[m][k], acc[ai][bj][m][n], 0, 0, 0); } } \
        __builtin_amdgcn_s_setprio(0); } while (0)
#define PG8_WAIT_V(n) asm volatile("s_waitcnt vmcnt(" #n ")" ::: "memory")
#define PG8_WAIT_L(n) asm volatile("s_waitcnt lgkmcnt(" #n ")" ::: "memory")
#define PG8_BAR __builtin_amdgcn_s_barrier()
#define PG8_SCHED __builtin_amdgcn_sched_barrier(0)
    Unit cur, nxt; int ui = 0;
    u32x4 pre[4][2];
    u32x2 carry[2][4][2];
    if constexpr (Epi::INPLACE) {
#pragma unroll
        for (int a = 0; a < 2; ++a)
#pragma unroll
            for (int m = 0; m < 4; ++m) { carry[a][m][0] = (u32x2){0u, 0u}; carry[a][m][1] = (u32x2){0u, 0u}; } }
    if (!S.next(0, cur)) return;
    f32x4 acc[2][2][4][2];
#pragma unroll
    for (int a = 0; a < 2; ++a)
#pragma unroll
        for (int b = 0; b < 2; ++b)
#pragma unroll
            for (int m = 0; m < 4; ++m)
#pragma unroll
                for (int n = 0; n < 2; ++n) acc[a][b][m][n] = (f32x4){0.f, 0.f, 0.f, 0.f};
    const int sc8_ = SC8;
    bf16x8 At[4][2], B0[2][2], B1[2][2]; v8i32 At8[4], B08[2], B18[2];
    const char* cA = (const char*)g.A + ((size_t)cur.be * g.astride) * 2 + (GATHER ? (size_t)0 : (size_t)cur.pm * 2 * hsA); if constexpr (GATHER) gather_offs(cur.pm, gA0, gA1);
    const char* cB = (const char*)g.Bt + ((size_t)cur.be * g.bstride) * 2 + (size_t)cur.pn * 2 * hsB;
    PG8_STAGE(PG8_SB(0, 0), cB, voffB); PG8_STAGE(PG8_SB(0, 1), cB + hsB, voffB); PG8_STA(PG8_SA(0, 0), 0, cA, false); PG8_STA(PG8_SA(0, 1), 1, cA, false);
    if (wr == 1) PG8_BAR;
    PG8_WAIT_V(2); PG8_BAR;
    PG8_STAGE(PG8_SB(1, 0), cB + kstep, voffB); PG8_STA(PG8_SA(1, 0), 0, cA + kstep, false); PG8_STAGE(PG8_SB(1, 1), cB + hsB + kstep, voffB);
    PG8_WAIT_V(6); PG8_BAR;
    for (;;) {
        const bool has_next = S.next(ui + 1, nxt);
        if constexpr (Epi::PRELOAD) { const int l3_ = fresh_tid(wid) & 63; E.preload(pre, cur, wr, wc, l3_ & 15, l3_ >> 4); }
        const char* nA = has_next ? (const char*)g.A + ((size_t)nxt.be * g.astride) * 2 + (GATHER ? (size_t)0 : (size_t)nxt.pm * 2 * hsA) : cA;
        if constexpr (GATHER) { if (has_next) gather_offs(nxt.pm, nG0, nG1); else { nG0[0] = gA0[0]; nG0[1] = gA0[1]; nG1[0] = gA1[0]; nG1[1] = gA1[1]; } }
        const char* nB = has_next ? (const char*)g.Bt + ((size_t)nxt.be * g.bstride) * 2 + (size_t)nxt.pn * 2 * hsB : cB;
        for (int t = 0; t < nt; t += 2) {
            const bool last = (t == nt - 2);
            const char* a1 = cA + (size_t)(t + 1) * kstep;
            const char* a2 = last ? nA : cA + (size_t)(t + 2) * kstep; const char* b2 = last ? nB : cB + (size_t)(t + 2) * kstep;
            const char* a3 = a2 + kstep; const char* b3 = b2 + kstep;
            PG8_LDB(B0, 0, 0); PG8_LDB(B1, 0, 1); PG8_SCHED; PG8_LDA(At, 0, 0); PG8_STA(PG8_SA(1, 1), 1, a1, false);
            PG8_WAIT_V(8); PG8_WAIT_L(0); PG8_BAR; PG8_MMA(0, 0, At, B0); PG8_MMA(0, 1, At, B1); PG8_BAR; PG8_SCHED;
            PG8_LDA(At, 0, 1); PG8_STAGE(PG8_SB(0, 0), b2, voffB); PG8_STAGE(PG8_SB(0, 1), b2 + hsB, voffB); PG8_STA(PG8_SA(0, 0), 0, a2, last);
            PG8_WAIT_V(8); PG8_WAIT_L(0); PG8_BAR; PG8_MMA(1, 0, At, B0); PG8_MMA(1, 1, At, B1); PG8_BAR; PG8_SCHED;
            PG8_LDB(B0, 1, 0); PG8_LDB(B1, 1, 1); PG8_SCHED; PG8_LDA(At, 1, 0); PG8_STA(PG8_SA(0, 1), 1, a2, last);
            PG8_WAIT_V(8); PG8_WAIT_L(0); PG8_BAR; PG8_MMA(0, 0, At, B0); PG8_MMA(0, 1, At, B1); PG8_BAR; PG8_SCHED;
            PG8_LDA(At, 1, 1); PG8_STAGE(PG8_SB(1, 0), b3, voffB); PG8_STAGE(PG8_SB(1, 1), b3 + hsB, voffB); PG8_STA(PG8_SA(1, 0), 0, a3, last);
            PG8_WAIT_V(8); PG8_WAIT_L(0); PG8_BAR; PG8_MMA(1, 0, At, B0); PG8_MMA(1, 1, At, B1); PG8_BAR; PG8_SCHED;
        }
        if constexpr (ALIGN_EPI) { if (wr == 0) PG8_BAR; }
        if constexpr (FP8) asm volatile("s_nop 15\n\ts_nop 15" ::: "memory");
        bool keep_acc = false;
#ifdef PROBE_EPI
        unsigned long long tq_ = 0; if (((PROBE_EPI >> Epi::PID) & 1) && is_thread0(wid)) tq_ = __builtin_amdgcn_s_memrealtime();
#endif
        { const int l2_ = fresh_tid(wid) & 63; if constexpr (Epi::INPLACE) keep_acc = E.link(acc, carry, cur, wr, wc, l2_ & 15, l2_ >> 4); else if constexpr (Epi::PRELOAD) E(acc, pre, cur, wr, wc, l2_ & 15, l2_ >> 4); else E(acc, cur, wr, wc, l2_ & 15, l2_ >> 4); }
#ifdef PROBE_EPI
        if (((PROBE_EPI >> Epi::PID) & 1) && is_thread0(wid)) { asm volatile("s_waitcnt vmcnt(0)" ::: "memory"); volatile LAS unsigned* mp = (volatile LAS unsigned*)(lds + (147456 - 1024)) + 16; mp[0] = mp[0] + (unsigned)(__builtin_amdgcn_s_memrealtime() - tq_); }
#endif
        if (!has_next) break;
        if (!keep_acc)
#pragma unroll
        for (int a = 0; a < 2; ++a)
#pragma unroll
            for (int b = 0; b < 2; ++b)
#pragma unroll
                for (int m = 0; m < 4; ++m)
#pragma unroll
                    for (int n = 0; n < 2; ++n) acc[a][b][m][n] = (f32x4){0.f, 0.f, 0.f, 0.f};
        cur = nxt; cA = nA; cB = nB; ++ui;
        if constexpr (GATHER) { gA0[0] = nG0[0]; gA0[1] = nG0[1]; gA1[0] = nG1[0]; gA1[1] = nG1[1]; }
        if constexpr (ALIGN_EPI) { if (wr == 1) PG8_BAR; }
    }
    PG8_WAIT_V(0);
    if constexpr (!ALIGN_EPI) { if (wr == 0) PG8_BAR; }
    PG8_BAR;
#undef PG8_SA
#undef PG8_SB
#undef PG8_STAGE
#undef PG8_STA
#undef PG8_LDA
#undef PG8_LDB
#undef PG8_MMA
#undef PG8_WAIT_V
#undef PG8_WAIT_L
#undef PG8_BAR
#undef PG8_SCHED
}

struct EpiBf16Plain {
    static constexpr bool PRELOAD = false; static constexpr int PID = 0; static constexpr bool PERM = true; static constexpr bool INPLACE = false;
    bf16_t* O; int ldc;
    __device__ __forceinline__ void operator()(const f32x4 (&acc)[2][2][4][2], const Unit& u, int wr, int wc, int fr_in, int fq_in) const {
        int fr = fr_in, fq = fq_in; asm volatile("" : "+v"(fr), "+v"(fq));
        const int row0 = u.pm * BM + wr * 64 + fr; const int col0 = u.pn * BM + wc * 32 + 8 * fq;
#pragma unroll
        for (int ai = 0; ai < 2; ++ai)
#pragma unroll
            for (int m = 0; m < 4; ++m) { bf16_t* rowp = O + (size_t)(row0 + ai * HALF + m * 16) * ldc + col0;
#pragma unroll
                for (int bj = 0; bj < 2; ++bj) { const f32x4 v0 = acc[ai][bj][m][0], v1 = acc[ai][bj][m][1];
                    u32x4 w; w.x = pk2(v0[0], v0[1]); w.y = pk2(v0[2], v0[3]); w.z = pk2(v1[0], v1[1]); w.w = pk2(v1[2], v1[3]);
                    *(u32x4*)(rowp + bj * HALF) = w; } }
    }
};
struct EpiProj {
    static constexpr bool PRELOAD = false; static constexpr int PID = 1; static constexpr bool PERM = true; static constexpr bool INPLACE = false;
    bf16_t* O; const float* gbias; const float* gq_a; const float* gk_a; const float* gq_b; const float* gk_b; float* kmean; LAS unsigned char* tab; unsigned long long segmap; size_t gofs; const float* rstd;
    __device__ __forceinline__ void operator()(const f32x4 (&acc)[2][2][4][2], const Unit& u, int wr, int wc, int fr, int fq) const {
        const int row0 = u.pm * BM + wr * 64 + fr; const int coltL = u.pn * BM;
        const int seg = (int)((segmap >> (4 * (coltL >> 10))) & 15ull), colt = seg * MIXW + (coltL & (MIXW - 1)), col0 = colt + wc * 32 + 8 * fq;
        const bool isnorm = (seg == 0) | (seg == 1) | (seg == 3) | (seg == 4);
        if (!isnorm) {
            const bool isgate = colt >= 9 * MIXW;
            if (isgate) {
                f32x4 bv[2][2];
#pragma unroll
                for (int bj = 0; bj < 2; ++bj)
#pragma unroll
                    for (int n = 0; n < 2; ++n) bv[bj][n] = *(const f32x4*)(gbias + (col0 - 9 * MIXW) + bj * HALF + 4 * n);
                unsigned char* gbase = (unsigned char*)O + gofs + (size_t)(col0 - 9 * MIXW);
#pragma unroll
                for (int ai = 0; ai < 2; ++ai)
#pragma unroll
                    for (int m = 0; m < 4; ++m) { unsigned char* rowp = gbase + (size_t)(row0 + ai * HALF + m * 16) * GP;
#pragma unroll
                        for (int bj = 0; bj < 2; ++bj) { const f32x4 v0 = acc[ai][bj][m][0] + bv[bj][0], v1 = acc[ai][bj][m][1] + bv[bj][1];
                            u32x2 w; w.x = pk4_u8(sigmoidf_(v0[0]), sigmoidf_(v0[1]), sigmoidf_(v0[2]), sigmoidf_(v0[3])); w.y = pk4_u8(sigmoidf_(v1[0]), sigmoidf_(v1[1]), sigmoidf_(v1[2]), sigmoidf_(v1[3]));
                            *(u32x2*)(rowp + bj * HALF) = w; } }
                return;
            }
#pragma unroll
            for (int ai = 0; ai < 2; ++ai)
#pragma unroll
                for (int m = 0; m < 4; ++m) { bf16_t* rowp = O + (size_t)(row0 + ai * HALF + m * 16) * QP + col0; const float rs_ = rstd ? rstd[row0 + ai * HALF + m * 16] : 1.0f;
#pragma unroll
                    for (int bj = 0; bj < 2; ++bj) { const f32x4 v0 = acc[ai][bj][m][0] * rs_, v1 = acc[ai][bj][m][1] * rs_;
                        u32x4 w; w.x = pk2(v0[0], v0[1]); w.y = pk2(v0[2], v0[3]); w.z = pk2(v1[0], v1[1]); w.w = pk2(v1[2], v1[3]);
                        *(u32x4*)(rowp + bj * HALF) = w; } }
            return;
        }
        float rsv[2][4];
#pragma unroll
        for (int ai = 0; ai < 2; ++ai)
#pragma unroll
            for (int m = 0; m < 4; ++m) rsv[ai][m] = rstd ? rstd[row0 + ai * HALF + m * 16] : 1.0f;
        f32x4 g0, g1; const int go = 32 * wc + 8 * fq;
        if (seg == 0)      { g0 = *(const f32x4*)(gq_a + go) * QSCALE2; g1 = *(const f32x4*)(gq_a + go + 4) * QSCALE2; }
        else if (seg == 1) { g0 = *(const f32x4*)(gk_a + go);           g1 = *(const f32x4*)(gk_a + go + 4); }
        else if (seg == 3) { g0 = *(const f32x4*)(gq_b + go) * QSCALE2; g1 = *(const f32x4*)(gq_b + go + 4) * QSCALE2; }
        else               { g0 = *(const f32x4*)(gk_b + go);           g1 = *(const f32x4*)(gk_b + go + 4); }
        LAS float* T = (LAS float*)tab;
        LAS float* KS = (LAS float*)(tab + 8192);
#pragma unroll
        for (int ai = 0; ai < 2; ++ai)
#pragma unroll
            for (int m = 0; m < 4; ++m)
#pragma unroll
                for (int bj = 0; bj < 2; ++bj) { const f32x4 v0 = acc[ai][bj][m][0] * rsv[ai][m], v1 = acc[ai][bj][m][1] * rsv[ai][m];
                    float ss = (v0[0] * v0[0] + v0[1] * v0[1]) + (v0[2] * v0[2] + v0[3] * v0[3]) + (v1[0] * v1[0] + v1[1] * v1[1]) + (v1[2] * v1[2] + v1[3] * v1[3]);
                    ss += shx(ss, 16, fq * 16 + fr); ss += shx(ss, 32, fq * 16 + fr);
                    if (fq == 0) T[((ai * HALF + wr * 64 + m * 16 + fr) * 2 + bj) * 4 + wc] = ss; }
        asm volatile("s_waitcnt lgkmcnt(0)" ::: "memory"); __builtin_amdgcn_s_barrier(); asm volatile("" ::: "memory");
        float cs[2][8];
#pragma unroll
        for (int bj = 0; bj < 2; ++bj)
#pragma unroll
            for (int j = 0; j < 8; ++j) cs[bj][j] = 0.f;
#pragma unroll
        for (int ai = 0; ai < 2; ++ai)
#pragma unroll
            for (int m = 0; m < 4; ++m) { const int rl = ai * HALF + wr * 64 + m * 16 + fr; bf16_t* rowp = O + (size_t)(u.pm * BM + rl) * QP + col0;
#pragma unroll
                for (int bj = 0; bj < 2; ++bj) { const f32x4 t = *(const LAS f32x4*)(T + (rl * 2 + bj) * 4);
                    const float rstd_h = 1.0f / sqrtf(((t.x + t.y) + (t.z + t.w)) * (1.f / HD) + RMS_EPS);
                    const f32x4 y0 = acc[ai][bj][m][0] * (rsv[ai][m] * rstd_h) * g0, y1 = acc[ai][bj][m][1] * (rsv[ai][m] * rstd_h) * g1;
                    cs[bj][0] += y0[0]; cs[bj][1] += y0[1]; cs[bj][2] += y0[2]; cs[bj][3] += y0[3]; cs[bj][4] += y1[0]; cs[bj][5] += y1[1]; cs[bj][6] += y1[2]; cs[bj][7] += y1[3];
                    u32x4 w; w.x = pk2(y0[0], y0[1]); w.y = pk2(y0[2], y0[3]); w.z = pk2(y1[0], y1[1]); w.w = pk2(y1[2], y1[3]);
                    *(u32x4*)(rowp + bj * HALF) = w; } }
        if (seg == 1) {
#pragma unroll
            for (int bj = 0; bj < 2; ++bj)
#pragma unroll
                for (int j = 0; j < 8; ++j) { float c = cs[bj][j]; c += shx(c, 1, fq * 16 + fr); c += shx(c, 2, fq * 16 + fr); c += shx(c, 4, fq * 16 + fr); c += shx(c, 8, fq * 16 + fr); cs[bj][j] = c; }
            if (fr == 0) {
#pragma unroll
                for (int bj = 0; bj < 2; ++bj) { LAS float* q = KS + wr * 256 + bj * HALF + wc * 32 + 8 * fq;
                    *(LAS f32x4*)q = (f32x4){cs[bj][0], cs[bj][1], cs[bj][2], cs[bj][3]}; *(LAS f32x4*)(q + 4) = (f32x4){cs[bj][4], cs[bj][5], cs[bj][6], cs[bj][7]}; }
            }
            asm volatile("s_waitcnt lgkmcnt(0)" ::: "memory"); __builtin_amdgcn_s_barrier(); asm volatile("" ::: "memory");
            const int tid = (wr * 4 + wc) * 64 + fq * 16 + fr;
            if (tid < 256) { const int c = colt - MIXW + tid;
                kmean[(((size_t)(u.pm >> 3) * 8 + (c >> 7)) * 8 + (u.pm & 7)) * HD + (c & 127)] = (KS[tid] + KS[256 + tid]) * (1.f / 256.f); }
        }
    }
};
struct EpiGateChain {
    static constexpr bool PRELOAD = false; static constexpr int PID = 2; static constexpr bool PERM = true; static constexpr bool INPLACE = true;
    const unsigned char* gate0; bf16_t* mixb;
    __device__ __forceinline__ bool link(f32x4 (&acc)[2][2][4][2], u32x2 (&carry)[2][4][2], const Unit& u, int wr, int wc, int fr, int fq) const {
        const int row0 = u.pm * BM + wr * 64 + fr, col0 = u.pn * BM + wc * 32 + 8 * fq; const int b = u.be; const bool first = (b == 0), last = (b == 2);
        const unsigned char* ga = gate0 + b * D + col0; const unsigned char* gb = gate0 + (b + 1) * D + col0;
#pragma unroll
        for (int ai = 0; ai < 2; ++ai) {
            u32x2 g1[4][2], g2[4][2];
#pragma unroll
            for (int m = 0; m < 4; ++m) { const size_t row = (size_t)(row0 + ai * HALF + m * 16);
#pragma unroll
                for (int bj = 0; bj < 2; ++bj) { if (first) g1[m][bj] = *(const u32x2*)(ga + row * GP + bj * HALF); else g1[m][bj] = carry[ai][m][bj];
                    if (!last) g2[m][bj] = *(const u32x2*)(gb + row * GP + bj * HALF); else g2[m][bj] = (u32x2){0u, 0u}; } }
#pragma unroll
            for (int m = 0; m < 4; ++m) { const size_t row = (size_t)(row0 + ai * HALF + m * 16);
#pragma unroll
                for (int bj = 0; bj < 2; ++bj) { const u32x2 p = g1[m][bj], q = g2[m][bj];
                    f32x4 r0, r1;
#pragma unroll
                    for (int j = 0; j < 4; ++j) { r0[j] = u8h(p.x, j) * (last ? (1.f / 256.f) : fast_rcp(u8h(q.x, j))); r1[j] = u8h(p.y, j) * (last ? (1.f / 256.f) : fast_rcp(u8h(q.y, j))); }
                    acc[ai][bj][m][0] = acc[ai][bj][m][0] * r0; acc[ai][bj][m][1] = acc[ai][bj][m][1] * r1;
                    carry[ai][m][bj] = q;
                    if (last) { const f32x4 v0 = acc[ai][bj][m][0], v1 = acc[ai][bj][m][1];
                        u32x4 o; o.x = pk2(v0[0], v0[1]); o.y = pk2(v0[2], v0[3]); o.z = pk2(v1[0], v1[1]); o.w = pk2(v1[2], v1[3]);
                        *(u32x4*)(mixb + row * D + col0 + bj * HALF) = o; } } }
            asm volatile("" ::: "memory");
        }
        return !last;
    }
};
struct EpiResid {
    static constexpr bool PRELOAD = true; static constexpr int PID = 3; static constexpr bool PERM = true; static constexpr bool INPLACE = false;
    bf16_t* xb;
    __device__ __forceinline__ void preload(u32x4 (&pre)[4][2], const Unit& u, int wr, int wc, int fr, int fq) const {
        const int row0 = u.pm * BM + wr * 64 + fr, col0 = u.pn * BM + wc * 32 + 8 * fq;
#pragma unroll
        for (int m = 0; m < 4; ++m) { const size_t off = (size_t)(row0 + m * 16) * D + col0;
#pragma unroll
            for (int bj = 0; bj < 2; ++bj) pre[m][bj] = *(const u32x4*)(xb + off + bj * HALF); }
    }
    __device__ __forceinline__ void operator()(const f32x4 (&acc)[2][2][4][2], const u32x4 (&pre)[4][2], const Unit& u, int wr, int wc, int fr_in, int fq_in) const {
        int fr = fr_in, fq = fq_in; asm volatile("" : "+v"(fr), "+v"(fq));
        const int row0 = u.pm * BM + wr * 64 + fr, col0 = u.pn * BM + wc * 32 + 8 * fq;
        u32x4 bs[4][2];
#pragma unroll
        for (int m = 0; m < 4; ++m) { const size_t off = (size_t)(row0 + HALF + m * 16) * D + col0;
#pragma unroll
            for (int bj = 0; bj < 2; ++bj) bs[m][bj] = *(const u32x4*)(xb + off + bj * HALF); }
#pragma unroll
        for (int ai = 0; ai < 2; ++ai) {
#pragma unroll
            for (int m = 0; m < 4; ++m) { const size_t off = (size_t)(row0 + ai * HALF + m * 16) * D + col0;
#pragma unroll
                for (int bj = 0; bj < 2; ++bj) { const f32x4 v0 = acc[ai][bj][m][0], v1 = acc[ai][bj][m][1]; const u32x4 b = ai ? bs[m][bj] : pre[m][bj];
                    u32x4 o; o.x = pk2(v0[0] + bflo(b.x), v0[1] + bfhi(b.x)); o.y = pk2(v0[2] + bflo(b.y), v0[3] + bfhi(b.y)); o.z = pk2(v1[0] + bflo(b.z), v1[1] + bfhi(b.z)); o.w = pk2(v1[2] + bflo(b.w), v1[3] + bfhi(b.w));
                    *(u32x4*)(xb + off + bj * HALF) = o; } }
            asm volatile("" ::: "memory");
        }
    }
};
struct EpiSwiglu {
    static constexpr bool PRELOAD = false; static constexpr int PID = 4; static constexpr bool PERM = true; static constexpr bool INPLACE = false;
    unsigned char* act;
    __device__ __forceinline__ void operator()(const f32x4 (&acc)[2][2][4][2], const Unit& u, int wr, int wc, int fr_in, int fq_in) const {
        int fr = fr_in, fq = fq_in; asm volatile("" : "+v"(fr), "+v"(fq));
        const int row0 = u.pm * BM + wr * 64 + fr; const int col0 = u.pn * BM + wc * 32 + 8 * fq;
#pragma unroll
        for (int ai = 0; ai < 2; ++ai)
#pragma unroll
            for (int m = 0; m < 4; ++m) { unsigned char* rowp = act + (size_t)(row0 + ai * HALF + m * 16) * FF + (col0 >> 1);
#pragma unroll
                for (int bj = 0; bj < 2; ++bj) { const f32x4 v0 = acc[ai][bj][m][0], v1 = acc[ai][bj][m][1];
                    const float a0 = v0[0] * sigmoidf_(v0[0]) * v0[1], a1 = v0[2] * sigmoidf_(v0[2]) * v0[3];
                    const float a2 = v1[0] * sigmoidf_(v1[0]) * v1[1], a3 = v1[2] * sigmoidf_(v1[2]) * v1[3];
                    *(unsigned*)(rowp + bj * (HALF / 2)) = pk4_fp8(a0 * 16.f, a1 * 16.f, a2 * 16.f, a3 * 16.f); } }
    }
};
}
constexpr int NWAVES = 8, NTHR = 512;
constexpr int RING_BYTES = 131072;
constexpr int MISC_OFF = 147456 - 1024;
constexpr int XTRA_OFF = RING_BYTES;
constexpr int LDS_BYTES = 147456 + 9216;
constexpr int LDS_BYTES_OLD_ = 147456;

struct Args {
    const float* x; const float* attn_norm_g; const float* w_in; const float* gate_bias;
    const float* moba_q_gain; const float* moba_k_gain; const float* diff_q_gain; const float* diff_k_gain;
    const float* lq1; const float* lk1; const float* lq2; const float* lk2; const float* diff_head_gain;
    const float* w_branch; const float* w_out; const float* ffn_norm_g; const float* w_rg; const float* w_re;
    const float* w_eg; const float* w_eu; const float* w_ed;
    float* out; unsigned char* ws;
    int step_lo, step_hi;
};

typedef const __attribute__((address_space(4))) Args* KArgs;
__device__ __forceinline__ KArgs fresh_args(KArgs p) { asm volatile("" : "+s"(p)); return p; }

#ifdef PROBE_SUB
#define SUBP_BEGIN(bit) unsigned long long sp_t_##bit = 0; if (((PROBE_SUB >> (bit)) & 1) && is_thread0(F.wave)) sp_t_##bit = __builtin_amdgcn_s_memrealtime();
#define SUBP_END(bit) if (((PROBE_SUB >> (bit)) & 1) && is_thread0(F.wave)) { const unsigned d_ = (unsigned)(__builtin_amdgcn_s_memrealtime() - sp_t_##bit); F.MISC[16] = F.MISC[16] + d_; }
#else
#define SUBP_BEGIN(bit)
#define SUBP_END(bit)
#endif
struct Frame {
    LAS unsigned char* lds; volatile LAS unsigned* MISC; unsigned* ctl;
    int tid, lane, wave, G, bid;
};

__device__ __forceinline__ void wconv_item(const float* W, int K, int N, bf16_t* WT, int row_off, int row_mul, LAS float* scr, int item, int lane, const float* ksc = nullptr) {
    const int nblk = N / 32, kb = item / nblk, nb = item % nblk, k0 = 64 * kb, n0 = 32 * nb;
    { f32x4 t[8];
#pragma unroll
      for (int i = 0; i < 8; ++i) t[i] = __builtin_nontemporal_load((const f32x4*)(W + (size_t)(k0 + 8 * i + (lane >> 3)) * N + n0 + 4 * (lane & 7)));
      if (ksc) {
#pragma unroll
          for (int i = 0; i < 8; ++i) t[i] = t[i] * ksc[k0 + 8 * i + (lane >> 3)]; }
#pragma unroll
      for (int i = 0; i < 8; ++i) { LAS float* q = scr + (8 * i + (lane >> 3)) * 33 + 4 * (lane & 7); q[0] = t[i].x; q[1] = t[i].y; q[2] = t[i].z; q[3] = t[i].w; } }
    LDS_WAIT(); asm volatile("" ::: "memory");
    const int c = lane & 7;
#pragma unroll
    for (int j = 0; j < 4; ++j) { const int n = (lane >> 3) + 8 * j; const LAS float* s = scr + (8 * c) * 33 + n;
        u32x4 o; o.x = pk2(s[0 * 33], s[1 * 33]); o.y = pk2(s[2 * 33], s[3 * 33]); o.z = pk2(s[4 * 33], s[5 * 33]); o.w = pk2(s[6 * 33], s[7 * 33]);
        *(u32x4*)(WT + (size_t)(row_off + (n0 + n) * row_mul) * K + k0 + 8 * c) = o; }
    LDS_WAIT(); asm volatile("" ::: "memory");
}
__device__ __forceinline__ void wconv_item8(const float* W, int K, int N, unsigned char* WT8, int row0, int n0, int k0, LAS float* scr, int lane, int row_mul = 1) {
    { f32x4 t[8];
#pragma unroll
      for (int i = 0; i < 8; ++i) t[i] = __builtin_nontemporal_load((const f32x4*)(W + (size_t)(k0 + 8 * i + (lane >> 3)) * N + n0 + 4 * (lane & 7)));
#pragma unroll
      for (int i = 0; i < 8; ++i) { LAS float* q = scr + (8 * i + (lane >> 3)) * 33 + 4 * (lane & 7); q[0] = t[i].x; q[1] = t[i].y; q[2] = t[i].z; q[3] = t[i].w; } }
    LDS_WAIT(); asm volatile("" ::: "memory");
    const int c = lane & 7;
#pragma unroll
    for (int j = 0; j < 4; ++j) { const int n = (lane >> 3) + 8 * j; const LAS float* s = scr + (8 * c) * 33 + n;
        u32x2 o; o.x = pk4_fp8(s[0 * 33] * 64.f, s[1 * 33] * 64.f, s[2 * 33] * 64.f, s[3 * 33] * 64.f); o.y = pk4_fp8(s[4 * 33] * 64.f, s[5 * 33] * 64.f, s[6 * 33] * 64.f, s[7 * 33] * 64.f);
        *(u32x2*)(WT8 + (size_t)(row0 + n * row_mul) * K + k0 + 8 * c) = o; }
    LDS_WAIT(); asm volatile("" ::: "memory");
}
constexpr int WC_I_IN = (D / 64) * (INC / 32), WC_NITEMS = WC_I_IN + 3 * (MIXW / 64) * (D / 32) + (D / 64) * (D / 32) + 2 * NEXP * (D / 64) * (FF / 32) + NEXP * (FF / 64) * (D / 32);
__device__ __forceinline__ void phase_wconv(const Frame& F0, KArgs a0, int layer, int it_lo = 0, int it_hi = WC_NITEMS, int w0 = 0, int nw = 0) {
    Frame F = F0; F.tid = fresh_tid(F0.wave); F.lane = F.tid & 63; F.wave = __builtin_amdgcn_readfirstlane(F.tid >> 6); const KArgs a = fresh_args(a0); unsigned char* const ws_ = a->ws; F.ctl = (unsigned*)(ws_ + WS_CTL);
    LAS float* scr = (LAS float*)(F.lds + F.wave * 16384);
    unsigned char* ws = ws_;
    bf16_t* win_t = (bf16_t*)(ws + WS_WIN); bf16_t* wbr_t = (bf16_t*)(ws + WS_WBR); bf16_t* wout_t = (bf16_t*)(ws + WS_WOUT);
    bf16_t* wgu_t = (bf16_t*)(ws + WS_WGU); bf16_t* wd_t = (bf16_t*)(ws + WS_WD);
    constexpr int I_IN = (D / 64) * (INC / 32), I_BR = (MIXW / 64) * (D / 32), I_OUT = (D / 64) * (D / 32), I_G = (D / 64) * (FF / 32), I_D = (FF / 64) * (D / 32);
    constexpr int NITEMS = I_IN + 3 * I_BR + I_OUT + 2 * NEXP * I_G + NEXP * I_D;
    static_assert(WC_I_IN == I_IN && WC_NITEMS == NITEMS, "wconv item counts");
    if (nw <= 0) nw = F.G;
    if (F.bid < w0 || F.bid >= w0 + nw) return;
    const int gw = (F.bid - w0) * NWAVES + F.wave, NGW = nw * NWAVES;
    for (int it = it_lo + gw; it < it_hi; it += NGW) {
        int r = it;
        if (r < I_IN) {
            const int nblk = INC / 32, kb = r / nblk, nb = r % nblk, n0 = 32 * nb, seg = n0 >> 10;
            const float* W = a->w_in + (size_t)layer * D * INC;
            const int f8blk = seg <= 2 ? seg : (seg == 6 || seg == 7) ? seg - 3 : (seg >= 9 ? seg - 4 : -1);
            if (f8blk >= 0) wconv_item8(W, D, INC, (unsigned char*)(ws + WS_WIN8), f8blk * MIXW + (n0 & (MIXW - 1)), n0, 64 * kb, scr, F.lane);
            else wconv_item(W, D, INC, win_t, (seg == 8 ? 3 : seg - 3) * MIXW - n0 + (n0 & (MIXW - 1)), 1, scr, r, F.lane, a->attn_norm_g + layer * D);
            continue; } r -= I_IN;
        if (r < 3 * I_BR) { const int g = r / I_BR; wconv_item(a->w_branch + (size_t)(layer * 3 + g) * MIXW * D, MIXW, D, wbr_t + (size_t)g * D * MIXW, 0, 1, scr, r % I_BR, F.lane); continue; } r -= 3 * I_BR;
        if (r < I_OUT) { wconv_item(a->w_out + (size_t)layer * D * D, D, D, wout_t, 0, 1, scr, r, F.lane); continue; } r -= I_OUT;
        if (r < NEXP * I_G) { const int e = r / I_G, it2 = r % I_G, nblk = FF / 32, kb = it2 / nblk, n0 = 32 * (it2 % nblk); wconv_item8(a->w_eg + (size_t)(layer * NEXP + e) * D * FF, D, FF, (unsigned char*)wgu_t + (size_t)e * 2 * FF * D, 2 * n0, n0, 64 * kb, scr, F.lane, 2); continue; } r -= NEXP * I_G;
        if (r < NEXP * I_G) { const int e = r / I_G, it2 = r % I_G, nblk = FF / 32, kb = it2 / nblk, n0 = 32 * (it2 % nblk); wconv_item8(a->w_eu + (size_t)(layer * NEXP + e) * D * FF, D, FF, (unsigned char*)wgu_t + (size_t)e * 2 * FF * D, 2 * n0 + 1, n0, 64 * kb, scr, F.lane, 2); continue; } r -= NEXP * I_G;
        { const int e = r / I_D, it2 = r % I_D, nblk = D / 32, kb = it2 / nblk, n0 = 32 * (it2 % nblk); wconv_item8(a->w_ed + (size_t)(layer * NEXP + e) * FF * D, FF, D, (unsigned char*)wd_t + (size_t)e * D * FF, n0, n0, 64 * kb, scr, F.lane); }
    }
}

__device__ __forceinline__ void rms_row_to_bf16(const f32x4 (&v)[8], const float* gain, bf16_t* orow, unsigned char* o8row, int lane) {
    f32x4 g[8];
#pragma unroll
    for (int j = 0; j < 8; ++j) g[j] = *((const f32x4*)gain + lane + 64 * j);
    float s = 0.f;
#pragma unroll
    for (int j = 0; j < 8; ++j) s += (v[j].x * v[j].x + v[j].y * v[j].y) + (v[j].z * v[j].z + v[j].w * v[j].w);
    const float rstd = 1.0f / sqrtf(wave_sum(s, lane) * (1.f / D) + RMS_EPS);
    u32x2* o8 = (u32x2*)orow + lane; unsigned* q8 = (unsigned*)o8row + lane;
#pragma unroll
    for (int j = 0; j < 8; ++j) { const f32x4 y = v[j] * rstd * g[j]; u32x2 o; o.x = pk2(y.x, y.y); o.y = pk2(y.z, y.w); o8[64 * j] = o;
        if (o8row) q8[64 * j] = pk4_fp8(y.x, y.y, y.z, y.w); }
}
__device__ __forceinline__ void rms_row_to_fp8(const f32x4 (&v)[8], const float* gain, unsigned char* o8row, float* rs_out, int lane) {
    f32x4 g[8];
#pragma unroll
    for (int j = 0; j < 8; ++j) g[j] = *((const f32x4*)gain + lane + 64 * j);
    float s = 0.f;
#pragma unroll
    for (int j = 0; j < 8; ++j) s += (v[j].x * v[j].x + v[j].y * v[j].y) + (v[j].z * v[j].z + v[j].w * v[j].w);
    const float rstd = 1.0f / sqrtf(wave_sum(s, lane) * (1.f / D) + RMS_EPS);
    if (lane == 0) *rs_out = rstd;
    unsigned* q8 = (unsigned*)o8row + lane;
#pragma unroll
    for (int j = 0; j < 8; ++j) { const f32x4 y = v[j] * rstd * g[j]; q8[64 * j] = pk4_fp8(y.x, y.y, y.z, y.w); }
}
__device__ __forceinline__ void phase_norm0(const Frame& F0, KArgs a0) {
    Frame F = F0; F.tid = fresh_tid(F0.wave); F.lane = F.tid & 63; F.wave = __builtin_amdgcn_readfirstlane(F.tid >> 6); const KArgs a = fresh_args(a0); unsigned char* const ws_ = a->ws; F.ctl = (unsigned*)(ws_ + WS_CTL);
    bf16_t* H = (bf16_t*)(ws_ + WS_H); unsigned char* H8 = ws_ + WS_H8; bf16_t* XB = (bf16_t*)(ws_ + WS_XB);
    const int gw = F.bid * NWAVES + F.wave, NGW = F.G * NWAVES;
    for (int m = gw; m < NTOK; m += 2 * NGW) {
        const int m2 = m + NGW;
        const f32x4* xr = (const f32x4*)(a->x + (size_t)m * D) + F.lane; const f32x4* xr2 = (const f32x4*)(a->x + (size_t)(m2 < NTOK ? m2 : m) * D) + F.lane; f32x4 v[8], v2[8];
#pragma unroll
        for (int j = 0; j < 8; ++j) { v[j] = __builtin_nontemporal_load(xr + 64 * j); v2[j] = __builtin_nontemporal_load(xr2 + 64 * j); }
        { u32x2* xo = (u32x2*)(XB + (size_t)m * D) + F.lane; u32x2* xo2 = (u32x2*)(XB + (size_t)(m2 < NTOK ? m2 : m) * D) + F.lane;
#pragma unroll
          for (int j = 0; j < 8; ++j) { u32x2 o; o.x = pk2(v[j].x, v[j].y); o.y = pk2(v[j].z, v[j].w); xo[64 * j] = o; if (m2 < NTOK) { u32x2 o2; o2.x = pk2(v2[j].x, v2[j].y); o2.y = pk2(v2[j].z, v2[j].w); xo2[64 * j] = o2; } } }
        rms_row_to_fp8(v, a->attn_norm_g, H8 + (size_t)m * D, (float*)(ws_ + WS_RSTD) + m, F.lane);
        if (m2 < NTOK) rms_row_to_fp8(v2, a->attn_norm_g, H8 + (size_t)m2 * D, (float*)(ws_ + WS_RSTD) + m2, F.lane);
    }
}
#define MFMA32(a, b, c) __builtin_amdgcn_mfma_f32_32x32x16_bf16((a), (b), (c), 0, 0, 0)
constexpr int KROW = 272, VROW = 136;
constexpr int AT_K0 = 0, AT_K1 = 64 * KROW, AT_V = 2 * 64 * KROW, AT_LX = AT_V + 64 * 576, AT_KM = AT_LX + 1024, AT_Q = ((AT_KM + 8 * 128 * 4 + 255) / 256) * 256, AT_END = AT_Q + 8 * 8 * 64 * 16;
constexpr int AT_WQ = MISC_OFF - 256, AT_SC = AT_WQ + 64;
static_assert(AT_END <= AT_WQ && AT_SC + 64 <= MISC_OFF, "attention LDS");

__device__ __forceinline__ float xhalf_sum(float x) { const auto rr = __builtin_amdgcn_permlane32_swap(__float_as_uint(x), __float_as_uint(x), false, false); return __uint_as_float(rr[0]) + __uint_as_float(rr[1]); }
__device__ __forceinline__ float xhalf_partner(float x, int hh) { const auto rr = __builtin_amdgcn_permlane32_swap(__float_as_uint(x), __float_as_uint(x), false, false); return __uint_as_float(hh ? rr[0] : rr[1]); }
__device__ __forceinline__ bf16x8 pack8(const f32x16& p, int s) {
    u32x4 w;
    if (s == 0) { w.x = pk2(p[0], p[1]); w.y = pk2(p[2], p[3]); w.z = pk2(p[4], p[5]); w.w = pk2(p[6], p[7]); }
    else        { w.x = pk2(p[8], p[9]); w.y = pk2(p[10], p[11]); w.z = pk2(p[12], p[13]); w.w = pk2(p[14], p[15]); }
    return __builtin_bit_cast(bf16x8, w);
}
__device__ __forceinline__ f32x16 zero16() { f32x16 z;
#pragma unroll
    for (int i = 0; i < 16; ++i) z[i] = 0.f;
    return z; }
template <bool LIM = false>
__device__ __forceinline__ f32x16 qk_block(const LAS unsigned char* Kl, int kb, int r, int hh, const bf16x8 (&qf)[8]) {
    f32x16 S = zero16();
    __builtin_amdgcn_s_setprio(1);
#pragma unroll
    for (int s = 0; s < 8; ++s) { const bf16x8 kf = *(const LAS bf16x8*)(Kl + (32 * kb + r) * KROW + (16 * s + 8 * hh) * 2); S = MFMA32(kf, qf[s], S);
        if (LIM && s == 3) __builtin_amdgcn_sched_barrier(0); }
    __builtin_amdgcn_s_setprio(0);
    return S;
}
template <bool LIM = false>
__device__ __forceinline__ void pv_block(const LAS unsigned char* Vl, int drow0, int kb, int r, int hh, const f32x16& p, f32x16 (&O)[4]) {
    const bf16x8 pk0 = pack8(p, 0), pk1 = pack8(p, 1);
#pragma unroll
    for (int db = 0; db < 4; ++db) {
#pragma unroll
        for (int s2 = 0; s2 < 2; ++s2) {
            const LAS unsigned char* ap = Vl + (drow0 + 32 * db + r) * VROW + (32 * kb + 16 * s2 + 4 * hh) * 2;
            const s16x4 lo = *(const LAS s16x4*)ap, hi = *(const LAS s16x4*)(ap + 16);
            const bf16x8 vf = __builtin_shufflevector(lo, hi, 0, 1, 2, 3, 4, 5, 6, 7);
            O[db] = MFMA32(vf, s2 ? pk1 : pk0, O[db]);
        }
        if (LIM && (db & 1)) __builtin_amdgcn_sched_barrier(0);
    }
}
typedef __amdgpu_buffer_rsrc_t rsrc_t;
__device__ __forceinline__ rsrc_t make_rsrc(const void* p, unsigned bytes) { return __builtin_amdgcn_make_buffer_rsrc((void*)p, 0, bytes, 0x00020000); }
__device__ __forceinline__ u32x4 bload16(rsrc_t rs, unsigned voff, unsigned soff) { return __builtin_bit_cast(u32x4, __builtin_amdgcn_raw_buffer_load_b128(rs, voff, soff, 0)); }
__device__ __forceinline__ void k_fetch(u32x4 (&pre)[2], rsrc_t rs, unsigned soff, int tid) {
#pragma unroll
    for (int i = 0; i < 2; ++i) { const unsigned c = (unsigned)tid + 512u * i, key = c >> 4, part = c & 15u; pre[i] = bload16(rs, key * (unsigned)(QP * 2) + part * 16u, soff); }
}
__device__ __forceinline__ void k_stash(const u32x4 (&pre)[2], LAS unsigned char* Kl, int tid) {
#pragma unroll
    for (int i = 0; i < 2; ++i) { const int c = tid + 512 * i, key = c >> 4, part = c & 15; *(LAS u32x4*)(Kl + key * KROW + part * 16) = pre[i]; }
}
template <int NCHK> __device__ __forceinline__ void v_fetch(u32x4 (&pre)[NCHK], rsrc_t rs, unsigned soff, int tid) {
#pragma unroll
    for (int i = 0; i < NCHK; ++i) { const unsigned c = (unsigned)tid + 512u * i, d = c >> 3, part = c & 7u; pre[i] = bload16(rs, d * (unsigned)(SEQ * 2) + part * 16u, soff); }
}
template <int NCHK> __device__ __forceinline__ void v_stash(const u32x4 (&pre)[NCHK], LAS unsigned char* Vl, int tid) {
#pragma unroll
    for (int i = 0; i < NCHK; ++i) { const int c = tid + 512 * i, d = c >> 3, part = c & 7; LAS u32x2* q = (LAS u32x2*)(Vl + d * VROW + part * 16);
        q[0] = (u32x2){pre[i].x, pre[i].y}; q[1] = (u32x2){pre[i].z, pre[i].w}; }
}
__device__ __forceinline__ void store_ot(const f32x16 (&O)[4], bf16_t* orow  , int hh, float sc) {
#pragma unroll
    for (int db = 0; db < 4; ++db)
#pragma unroll
        for (int g = 0; g < 4; ++g) { u32x2 o; o.x = pk2(O[db][4 * g] * sc, O[db][4 * g + 1] * sc); o.y = pk2(O[db][4 * g + 2] * sc, O[db][4 * g + 3] * sc);
            *(u32x2*)(orow + 32 * db + 8 * g + 4 * hh) = o; }
}

typedef short v4i16_t __attribute__((ext_vector_type(4)));
__device__ __forceinline__ s16x4 vtr(const LAS unsigned char* p) { return __builtin_bit_cast(s16x4, __builtin_amdgcn_ds_read_tr16_b64_v4i16((LAS v4i16_t*)p)); }
template <int NIMG> __device__ __forceinline__ void vrm_fetch(u32x4 (&pre)[2 * NIMG], rsrc_t rs, unsigned soff, int tid) {
#pragma unroll
    for (int i = 0; i < 2 * NIMG; ++i) { const unsigned c = (unsigned)tid + 512u * i, key = c / (16u * NIMG), cc = c % (16u * NIMG); pre[i] = bload16(rs, key * (unsigned)(QP * 2) + cc * 16u, soff); }
}
template <int NIMG> __device__ __forceinline__ void vrm_stash(const u32x4 (&pre)[2 * NIMG], LAS unsigned char* Vl, int tid) {
    constexpr unsigned VP = 256u * NIMG + 64u;
#pragma unroll
    for (int i = 0; i < 2 * NIMG; ++i) { const unsigned c = (unsigned)tid + 512u * i, key = c / (16u * NIMG), cc = c % (16u * NIMG); *(LAS u32x4*)(Vl + key * VP + cc * 16u) = pre[i]; }
}
template <int NIMG> __device__ __forceinline__ void pv_tr(const LAS unsigned char* Vl, int kb, int lane, const f32x16& p, f32x16 (&O)[4 * NIMG]) {
    constexpr unsigned VP = 256u * NIMG + 64u;
    const bf16x8 pk0 = pack8(p, 0), pk1 = pack8(p, 1);
    const unsigned hh = (unsigned)lane >> 5, blk = ((unsigned)lane >> 4) & 1u, q = ((unsigned)lane & 15u) >> 2, pp = (unsigned)lane & 3u;
    const LAS unsigned char* vb = Vl + (4u * hh + q) * VP + 32u * blk + 8u * pp;
    __builtin_amdgcn_s_setprio(1);
#pragma unroll
    for (int db = 0; db < 4 * NIMG; ++db) {
#pragma unroll
        for (int s2 = 0; s2 < 2; ++s2) {
            const s16x4 lo = vtr(vb + (32 * kb + 16 * s2) * VP + 64 * db), hi = vtr(vb + (32 * kb + 16 * s2 + 8) * VP + 64 * db);
            const bf16x8 vf = __builtin_shufflevector(lo, hi, 0, 1, 2, 3, 4, 5, 6, 7);
            O[db] = MFMA32(vf, s2 ? pk1 : pk0, O[db]);
        }
    }
    __builtin_amdgcn_s_setprio(0);
}

template <int MODE>
__device__ __forceinline__ void attn_unit_ac(LAS unsigned char* lds, int w, const bf16_t* Qp, const bf16_t* Kp, const bf16_t* Vp, bf16_t* Op, int q0, float slope2, const float* kmean_bh) {
    const int tid = fresh_tid(w); w = __builtin_amdgcn_readfirstlane(tid >> 6); const int lane = tid & 63, r = lane & 31, hh = lane >> 5;
    const int wq0 = q0 + 32 * w, tq = wq0 + r;
    LAS unsigned char* Kl = lds + AT_K0; LAS unsigned char* Vl = lds + AT_V;
    bf16x8 qf[8];
#pragma unroll
    for (int s = 0; s < 8; ++s) qf[s] = *(const bf16x8*)(Qp + (size_t)tq * QP + 16 * s + 8 * hh);
    const int own = q0 >> 8;
    unsigned selmask = 0u;
    if (MODE == 0) {
        LAS float* KM = (LAS float*)(lds + AT_KM);
        for (int idx = tid; idx < own * HD; idx += NTHR) KM[idx] = kmean_bh[idx];
        __syncthreads();
        float gsc[7];
#pragma unroll
        for (int n = 0; n < 7; ++n) {
            float acc = 0.f;
            if (n < own) {
#pragma unroll
                for (int s = 0; s < 8; ++s) { const f32x4 k0v = *(const LAS f32x4*)(KM + n * HD + 16 * s + 8 * hh), k1v = *(const LAS f32x4*)(KM + n * HD + 16 * s + 8 * hh + 4);
                    acc += bf2f((unsigned short)qf[s][0]) * k0v.x + bf2f((unsigned short)qf[s][1]) * k0v.y + bf2f((unsigned short)qf[s][2]) * k0v.z + bf2f((unsigned short)qf[s][3]) * k0v.w
                         + bf2f((unsigned short)qf[s][4]) * k1v.x + bf2f((unsigned short)qf[s][5]) * k1v.y + bf2f((unsigned short)qf[s][6]) * k1v.z + bf2f((unsigned short)qf[s][7]) * k1v.w; }
            }
            gsc[n] = xhalf_sum(acc);
        }
        if (own <= 3) selmask = (1u << own) - 1u;
        else {
#pragma unroll
            for (int pick = 0; pick < 3; ++pick) { float best = -__builtin_inff(); int bi = 0;
#pragma unroll
                for (int n = 0; n < 7; ++n) { const bool ok = (n < own) && !((selmask >> n) & 1u) && (gsc[n] > best); best = ok ? gsc[n] : best; bi = ok ? n : bi; }
                selmask |= 1u << bi; }
        }
    }
    f32x16 O[4];
#pragma unroll
    for (int db = 0; db < 4; ++db) O[db] = zero16();
    float lsum = 0.f, prun = 1.f;
    bool wdone = false;
    volatile LAS unsigned* dflag = (volatile LAS unsigned*)(lds + AT_SC + 32);
    if (MODE == 2 && lane == 0) dflag[w] = 0u;
    const int kt_hi = (q0 >> 6) + 3;
    const int dmax = (MODE == 0) ? (int)(160.0f / slope2) + 1 : (1 << 20);
    const int kt_lo = (q0 - dmax > 0) ? ((q0 - dmax) >> 6) : 0;
    u32x4 pk_[2], pv_[2];
    const rsrc_t rsK = make_rsrc(Kp, (unsigned)SEQ * QP * 2u), rsV = make_rsrc(Vp, (unsigned)SEQ * QP * 2u);
    k_fetch(pk_, rsK, (unsigned)(kt_hi * 64) * (unsigned)(QP * 2), tid); vrm_fetch<1>(pv_, rsV, (unsigned)(kt_hi * 64) * (unsigned)(QP * 2), tid);
    int pbuf = 0;
    for (int kt = kt_hi; kt >= kt_lo; --kt) {
        const int bo = (MODE == 0) ? pbuf * 81920 : 0;
        int tl = tid; asm volatile("" : "+v"(tl)); const int lane_l = tl & 63, r_l = lane_l & 31, hh_l = lane_l >> 5;
        k_stash(pk_, Kl + bo, tl); vrm_stash<1>(pv_, Vl + bo, tl);
        __syncthreads();
        if (kt > kt_lo) { k_fetch(pk_, rsK, (unsigned)((kt - 1) * 64) * (unsigned)(QP * 2), tl); vrm_fetch<1>(pv_, rsV, (unsigned)((kt - 1) * 64) * (unsigned)(QP * 2), tl); }
        const int k0 = kt * 64, kb256 = kt >> 2;
        const bool diag = (kb256 == own);
        bool active = (MODE == 0) ? (k0 <= wq0 + 31 && k0 + 63 >= wq0 - dmax) : (k0 < wq0 + 31 && !wdone);
        const bool sel = ((selmask >> kb256) & 1u) != 0u;
        if (MODE == 0 && !diag) active = active && (__any(sel ? 1 : 0) != 0);
        if (active) {
#pragma unroll
            for (int kbi = 0; kbi < 2; ++kbi) {
                const int kb = 1 - kbi;
                f32x16 S = qk_block(Kl + bo, kb, r_l, hh_l, qf);
                const int kbase = k0 + 32 * kb + 4 * hh - tq;
                if (MODE == 0) {
                    const float base = slope2 * (float)kbase - ((const LAS float*)(lds + AT_SC))[0];
#pragma unroll
                    for (int i = 0; i < 16; ++i) { const int cI = (i & 3) + 8 * (i >> 2);
                        const float e = fast_exp2(S[i] + (base + slope2 * (float)cI));
                        const bool vis = diag ? (kbase + cI <= 0) : sel;
                        S[i] = vis ? e : 0.f; lsum += S[i]; }
                } else {
                    float sg[16], kp[16];
#pragma unroll
                    for (int i = 0; i < 16; ++i) { const int cI = (i & 3) + 8 * (i >> 2);
                        const float z = S[i] * QSCALE2;
                        const float en = fast_exp2(-fabsf(z)), rc = fast_rcp(1.0f + en), sm = en * rc;
                        const bool pos = z >= 0.f, vis = (kbase + cI < 0);
                        sg[i] = vis ? (pos ? rc : sm) : 0.f; kp[i] = vis ? (pos ? sm : rc) : 1.f; }
                    float G[4], Gp[4];
#pragma unroll
                    for (int g = 0; g < 4; ++g) { G[g] = (kp[4 * g] * kp[4 * g + 1]) * (kp[4 * g + 2] * kp[4 * g + 3]); Gp[g] = xhalf_partner(G[g], hh); }
                    float run = prun;
#pragma unroll
                    for (int g = 3; g >= 0; --g) {
                        float t = (hh == 0) ? run * Gp[g] : run;
                        S[4 * g + 3] = sg[4 * g + 3] * t; t *= kp[4 * g + 3];
                        S[4 * g + 2] = sg[4 * g + 2] * t; t *= kp[4 * g + 2];
                        S[4 * g + 1] = sg[4 * g + 1] * t; t *= kp[4 * g + 1];
                        S[4 * g + 0] = sg[4 * g + 0] * t;
                        run = run * (G[g] * Gp[g]);
                    }
                    prun = run;
                }
                pv_tr<1>(Vl + bo, kb, lane_l, S, O);
            }
            if (MODE == 2) { wdone = __all(prun == 0.0f) != 0; if (wdone && lane == 0) dflag[w] = 1u; }
        }
        pbuf ^= 1;
        if (MODE != 0) __syncthreads();
        if (MODE == 2) {
            const u32x4 f0 = *(const LAS u32x4*)(lds + AT_SC + 32), f1 = *(const LAS u32x4*)(lds + AT_SC + 48);
            if ((f0.x & f0.y & f0.z & f0.w & f1.x & f1.y & f1.z & f1.w) != 0u) break;
        }
    }
    float sc = 1.f;
    if (MODE == 0) { const float lt = xhalf_sum(lsum); sc = 1.0f / lt; }
    store_ot(O, Op + (size_t)tq * (3 * MIXW), hh, sc);
}

__device__ __forceinline__ void attn_unit_c(LAS unsigned char* lds, int w, const bf16_t* Qp, const bf16_t* Kp, const bf16_t* Vp, bf16_t* Op, int q0) {
    const int tid = fresh_tid(w); w = __builtin_amdgcn_readfirstlane(tid >> 6); const int lane = tid & 63, r = lane & 31, hh = lane >> 5;
    const int wq0 = q0 + 32 * w, tq = wq0 + r;
    LAS unsigned char* Vl = lds + w * (32 * 320);
    bf16x8 qf[8];
#pragma unroll
    for (int s = 0; s < 8; ++s) qf[s] = *(const bf16x8*)(Qp + (size_t)tq * QP + 16 * s + 8 * hh);
    const rsrc_t rsK = make_rsrc(Kp, (unsigned)SEQ * QP * 2u), rsV = make_rsrc(Vp, (unsigned)SEQ * QP * 2u);
    const unsigned kvo = (unsigned)r * (unsigned)(QP * 2) + 16u * hh;
    f32x16 O[4];
#pragma unroll
    for (int db = 0; db < 4; ++db) O[db] = zero16();
    float prun = 1.f;
    u32x4 kn[8], vn[8];
    int jb = wq0 >> 5;
    {
        const unsigned so = (unsigned)(jb * 32) * (unsigned)(QP * 2);
#pragma unroll
        for (int s = 0; s < 8; ++s) kn[s] = bload16(rsK, kvo + 32u * s, so);
#pragma unroll
        for (int i = 0; i < 8; ++i) { const unsigned c = (unsigned)lane + 64u * i; vn[i] = bload16(rsV, (c >> 4) * (unsigned)(QP * 2) + (c & 15u) * 16u, so); }
    }
    for (; jb >= 0; --jb) {
        u32x4 kc[8];
#pragma unroll
        for (int s = 0; s < 8; ++s) kc[s] = kn[s];
#pragma unroll
        for (int i = 0; i < 8; ++i) { const unsigned c = (unsigned)lane + 64u * i; *(LAS u32x4*)(Vl + (c >> 4) * 320u + (c & 15u) * 16u) = vn[i]; }
        if (jb > 0) {
            const unsigned so = (unsigned)((jb - 1) * 32) * (unsigned)(QP * 2);
#pragma unroll
            for (int s = 0; s < 8; ++s) kn[s] = bload16(rsK, kvo + 32u * s, so);
#pragma unroll
            for (int i = 0; i < 8; ++i) { const unsigned c = (unsigned)lane + 64u * i; vn[i] = bload16(rsV, (c >> 4) * (unsigned)(QP * 2) + (c & 15u) * 16u, so); }
        }
        f32x16 S = zero16();
#pragma unroll
        for (int s = 0; s < 8; ++s) S = MFMA32(__builtin_bit_cast(bf16x8, kc[s]), qf[s], S);
        const int kbase = jb * 32 + 4 * hh - tq;
        float sg[16], kp[16];
#pragma unroll
        for (int i = 0; i < 16; ++i) { const int cI = (i & 3) + 8 * (i >> 2);
            const float z = S[i] * QSCALE2;
            const float en = fast_exp2(-fabsf(z)), rc = fast_rcp(1.0f + en), sm = en * rc;
            const bool pos = z >= 0.f, vis = (kbase + cI < 0);
            sg[i] = vis ? (pos ? rc : sm) : 0.f; kp[i] = vis ? (pos ? sm : rc) : 1.f; }
        float G[4], Gp[4];
#pragma unroll
        for (int g = 0; g < 4; ++g) { G[g] = (kp[4 * g] * kp[4 * g + 1]) * (kp[4 * g + 2] * kp[4 * g + 3]); Gp[g] = xhalf_partner(G[g], hh); }
        float run = prun;
#pragma unroll
        for (int g = 3; g >= 0; --g) {
            float t = (hh == 0) ? run * Gp[g] : run;
            S[4 * g + 3] = sg[4 * g + 3] * t; t *= kp[4 * g + 3];
            S[4 * g + 2] = sg[4 * g + 2] * t; t *= kp[4 * g + 2];
            S[4 * g + 1] = sg[4 * g + 1] * t; t *= kp[4 * g + 1];
            S[4 * g + 0] = sg[4 * g + 0] * t;
            run = run * (G[g] * Gp[g]);
        }
        prun = run;
        {
            const bf16x8 pk0 = pack8(S, 0), pk1 = pack8(S, 1);
            const unsigned blk = ((unsigned)lane >> 4) & 1u, q = ((unsigned)lane & 15u) >> 2, pp = (unsigned)lane & 3u;
            const LAS unsigned char* vb = Vl + (4u * hh + q) * 320u + 32u * blk + 8u * pp;
#pragma unroll
            for (int db = 0; db < 4; ++db)
#pragma unroll
                for (int s2 = 0; s2 < 2; ++s2) { const s16x4 lo = vtr(vb + (16 * s2) * 320 + 64 * db), hi = vtr(vb + (16 * s2 + 8) * 320 + 64 * db);
                    O[db] = MFMA32(__builtin_shufflevector(lo, hi, 0, 1, 2, 3, 4, 5, 6, 7), s2 ? pk1 : pk0, O[db]); }
        }
        if (__all(prun == 0.0f)) break;
    }
    store_ot(O, Op + (size_t)tq * (3 * MIXW), hh, 1.0f);
}

template <int NDB>
__device__ __forceinline__ void pv_block_n(const LAS unsigned char* Vl, int kb, int r, int hh, const f32x16& p, f32x16 (&O)[NDB]) {
    const bf16x8 pk0 = pack8(p, 0), pk1 = pack8(p, 1);
#pragma unroll
    for (int db = 0; db < NDB; ++db) {
#pragma unroll
        for (int s2 = 0; s2 < 2; ++s2) {
            const LAS unsigned char* ap = Vl + (32 * db + r) * VROW + (32 * kb + 16 * s2 + 4 * hh) * 2;
            const s16x4 lo = *(const LAS s16x4*)ap, hi = *(const LAS s16x4*)(ap + 16);
            const bf16x8 vf = __builtin_shufflevector(lo, hi, 0, 1, 2, 3, 4, 5, 6, 7);
            O[db] = MFMA32(vf, s2 ? pk1 : pk0, O[db]);
        }
    }
}
__device__ __forceinline__ void attn_unit_b(LAS unsigned char* lds, int w, const bf16_t* Qp, const bf16_t* Kp, const bf16_t* Vp, bf16_t* Op, int q0, float slope2, const float* hgain) {
    const int tid = fresh_tid(w); w = __builtin_amdgcn_readfirstlane(tid >> 6); const int lane = tid & 63, r = lane & 31, hh = lane >> 5;
    const int qsub = w & 3, dh = w >> 2;
    const int wq0 = q0 + 32 * qsub, tq = wq0 + r;
    LAS unsigned char* Kl0 = lds + AT_K0; LAS unsigned char* Kl1 = lds + AT_K1; LAS unsigned char* Vl = lds + AT_V;
    const LAS unsigned char* Kmine = dh ? Kl1 : Kl0;
    LAS unsigned char* Ql = lds + AT_Q + (w * 8 * 64 + lane) * 16;
    bf16x8 qreg[8];
#pragma unroll
    for (int s = 0; s < 8; ++s) qreg[s] = *(const bf16x8*)(Qp + (size_t)tq * QP + dh * HD + 16 * s + 8 * hh);
    const int kt_hi = (q0 >> 6) + 1;
    const int dmax = (int)(160.0f / slope2) + 1;
    const int kt_lo = (q0 - dmax > 0) ? ((q0 - dmax) >> 6) : 0;
    float lsum = 0.f;
    f32x16 O[8];
#pragma unroll
    for (int db = 0; db < 8; ++db) O[db] = zero16();
    {
        u32x4 pa[2], pb[2], pv_[4];
        const rsrc_t rsK = make_rsrc(Kp, (unsigned)SEQ * QP * 2u), rsV = make_rsrc(Vp, (unsigned)SEQ * QP * 2u);
        k_fetch(pa, rsK, (unsigned)(kt_hi * 64) * (unsigned)(QP * 2), tid); k_fetch(pb, rsK, (unsigned)(kt_hi * 64) * (unsigned)(QP * 2) + HD * 2u, tid); vrm_fetch<2>(pv_, rsV, (unsigned)(kt_hi * 64) * (unsigned)(QP * 2), tid);
        int pbuf = 0;
        for (int kt = kt_hi; kt >= kt_lo; --kt) {
            const int bo = pbuf * AT_LX;
            int tl = tid; asm volatile("" : "+v"(tl));
            const int lane_l = tl & 63, r_l = lane_l & 31, hh_l = lane_l >> 5;
            k_stash(pa, Kl0 + bo, tl); k_stash(pb, Kl1 + bo, tl); vrm_stash<2>(pv_, Vl + bo, tl);
            __syncthreads();
            if (kt > kt_lo) { k_fetch(pa, rsK, (unsigned)((kt - 1) * 64) * (unsigned)(QP * 2), tl); k_fetch(pb, rsK, (unsigned)((kt - 1) * 64) * (unsigned)(QP * 2) + HD * 2u, tl); vrm_fetch<2>(pv_, rsV, (unsigned)((kt - 1) * 64) * (unsigned)(QP * 2), tl); }
            const int k0 = kt * 64;
            if (k0 <= wq0 + 31 && k0 + 63 >= wq0 - dmax) {
#pragma unroll
                for (int kb = 0; kb < 2; ++kb) {
                    const int kbase = k0 + 32 * kb + 4 * hh - tq; const float base = slope2 * (float)kbase - ((const LAS float*)(lds + AT_SC))[1];
                    f32x16 S = zero16();
#pragma unroll
                    for (int s = 0; s < 8; ++s) { const bf16x8 kf = *(const LAS bf16x8*)(Kmine + bo + (32 * kb + r_l) * KROW + (16 * s + 8 * hh_l) * 2); S = MFMA32(kf, qreg[s], S); }
#pragma unroll
                    for (int i = 0; i < 16; ++i) { const int cI = (i & 3) + 8 * (i >> 2); const float e = fast_exp2(S[i] + (base + slope2 * (float)cI)); S[i] = (kbase + cI <= 0) ? e : 0.f; lsum += S[i]; }
                    pv_tr<2>(Vl + bo, kb, lane_l, S, O);
                }
            }
            pbuf ^= 1;
        }
        __syncthreads();
    }
    {
        const float lam = ((volatile LAS float*)(lds + AT_SC))[2]; const float lt = xhalf_sum(lsum); const float sc = (dh ? -lam : 1.0f) / lt;
        const int lane = fresh_tid(w) & 63;
        LAS float* XL = (LAS float*)lds;
#pragma unroll
        for (int db = 0; db < 4; ++db)
#pragma unroll
            for (int i = 0; i < 16; ++i) { const float give = dh ? O[db][i] : O[db + 4][i]; XL[((w * 4 + db) * 16 + i) * 64 + lane] = give * sc; }
        __syncthreads();
        const int pw = w ^ 4;
#pragma unroll
        for (int db = 0; db < 4; ++db)
#pragma unroll
            for (int i = 0; i < 16; ++i) { const float mine = dh ? O[db + 4][i] : O[db][i]; O[db][i] = mine * sc + XL[((pw * 4 + db) * 16 + i) * 64 + lane]; }
        __syncthreads();
    }
    float ss = 0.f;
#pragma unroll
    for (int db = 0; db < 4; ++db)
#pragma unroll
        for (int i = 0; i < 16; ++i) ss += O[db][i] * O[db][i];
    ss = xhalf_sum(ss);
    const int tz = fresh_tid(w);
    const int lane2 = tz & 63, r2 = lane2 & 31, hh2 = lane2 >> 5, w2 = tz >> 6, qs2 = w2 & 3, dh2 = w2 >> 2;
    LAS float* LX = (LAS float*)(lds + AT_LX);
    if (hh2 == 0) LX[dh2 * 128 + 32 * qs2 + r2] = ss;
    __syncthreads();
    const float tot = LX[32 * qs2 + r2] + LX[128 + 32 * qs2 + r2];
    const float rstd = ((volatile LAS float*)(lds + AT_SC))[3] / sqrtf(tot * (1.f / 256.f) + RMS_EPS);
    bf16_t* orow = Op + (size_t)(q0 + 32 * qs2 + r2) * (3 * MIXW) + 128 * dh2;
#pragma unroll
    for (int db = 0; db < 4; ++db)
#pragma unroll
        for (int g = 0; g < 4; ++g) { const int d = 32 * db + 8 * g + 4 * hh2; const f32x4 hg = *(const f32x4*)(hgain + 128 * dh2 + d);
            u32x2 o; o.x = pk2(O[db][4 * g] * rstd * hg.x, O[db][4 * g + 1] * rstd * hg.y); o.y = pk2(O[db][4 * g + 2] * rstd * hg.z, O[db][4 * g + 3] * rstd * hg.w);
            *(u32x2*)(orow + d) = o; }
    __syncthreads();
}

__device__ __forceinline__ int wq_pop(unsigned* ctr, LAS unsigned char* lds, int wave) {
    volatile LAS unsigned* slot = (volatile LAS unsigned*)(lds + AT_WQ);
    __syncthreads();
    if (is_thread0(wave)) slot[0] = __hip_atomic_fetch_add(ctr, 1u, __ATOMIC_RELAXED, __HIP_MEMORY_SCOPE_AGENT);
    __syncthreads();
    return (int)__builtin_amdgcn_readfirstlane(slot[0]);
}
__device__ __forceinline__ void phase_attn(const Frame& F0, KArgs a0, int layer_in, int chunk) {
    int layer = layer_in; asm volatile("" : "+s"(layer));
    Frame F = F0; F.tid = fresh_tid(F0.wave); F.lane = F.tid & 63; F.wave = __builtin_amdgcn_readfirstlane(F.tid >> 6); const KArgs a = fresh_args(a0); unsigned char* const ws_ = a->ws; F.ctl = (unsigned*)(ws_ + WS_CTL);
    const bf16_t* PROJ = (const bf16_t*)(ws_ + WS_PROJ); bf16_t* BR = (bf16_t*)(ws_ + WS_BR) + (size_t)chunk * CHT * (3 * MIXW); const float* KMEAN = (const float*)(ws_ + WS_KMEAN);
    unsigned* wq = F.ctl + CW_WQ + ((layer * NCH + chunk) * 3) * 64;
    float gqa = fmaxf(fabsf(a->moba_q_gain[layer * HD + F.lane]), fabsf(a->moba_q_gain[layer * HD + 64 + F.lane]));
    float gka = fmaxf(fabsf(a->moba_k_gain[layer * HD + F.lane]), fabsf(a->moba_k_gain[layer * HD + 64 + F.lane]));
    float gqb = fmaxf(fabsf(a->diff_q_gain[layer * HD + F.lane]), fabsf(a->diff_q_gain[layer * HD + 64 + F.lane]));
    float gkb = fmaxf(fabsf(a->diff_k_gain[layer * HD + F.lane]), fabsf(a->diff_k_gain[layer * HD + 64 + F.lane]));
    {
        const float m2a_ = 128.f * QSCALE2 * wave_max(gqa, F.lane) * wave_max(gka, F.lane), m2b_ = 128.f * QSCALE2 * wave_max(gqb, F.lane) * wave_max(gkb, F.lane);
        const float s1 = wave_sum(a->lq1[layer * HD + F.lane] * a->lk1[layer * HD + F.lane] + a->lq1[layer * HD + 64 + F.lane] * a->lk1[layer * HD + 64 + F.lane], F.lane);
        const float s2 = wave_sum(a->lq2[layer * HD + F.lane] * a->lk2[layer * HD + F.lane] + a->lq2[layer * HD + 64 + F.lane] * a->lk2[layer * HD + 64 + F.lane], F.lane);
        const float lam_init = layer == 0 ? 0.2f : 0.35550906759096926f;
        static_assert(DEPTH == 2, "lam_init table");
        volatile LAS float* sc = (volatile LAS float*)(F.lds + AT_SC);
        __syncthreads();
        if (F.tid == 0) { sc[0] = m2a_; sc[1] = m2b_; sc[2] = expf(s1) - expf(s2) + lam_init; sc[3] = 1.0f - lam_init; }
        __syncthreads();
    }
    SUBP_BEGIN(5)
    for (bool first = true;; first = false) {
        int u; if (first) { __syncthreads(); u = F.bid; } else u = wq_pop(wq + 0 * 64, F.lds, F.wave) + F.G; if (u >= 16 * CHB * 4) break;
        const int qb = 15 - (u >> 5), b = (u & 31) >> 2, hb = u & 3;
        const float slope2 = exp2f(-2.0f * (float)(hb + 1)) * 1.4426950408889634f;
        const bf16_t* base = PROJ + (size_t)b * SEQ * QP;
        attn_unit_b(F.lds, F.wave, base + 3072 + hb * 256, base + 4096 + hb * 256, base + 5120 + hb * 256, BR + (size_t)b * SEQ * (3 * MIXW) + MIXW + hb * 256,
                    qb * 128, slope2, a->diff_head_gain + layer * 256);
    }
    SUBP_END(5)
    SUBP_BEGIN(6)
    for (bool first = true;; first = false) {
        int u; if (first) { __syncthreads(); u = F.bid; } else u = wq_pop(wq + 1 * 64, F.lds, F.wave) + F.G; if (u >= 8 * CHB * 8) break;
        const int qb = 7 - (u >> 6), b = (u & 63) >> 3, h = u & 7;
        const float slope2 = exp2f(-(float)(h + 1)) * 1.4426950408889634f;
        const bf16_t* base = PROJ + (size_t)b * SEQ * QP;
        attn_unit_ac<0>(F.lds, F.wave, base + h * HD, base + 1024 + h * HD, base + 2048 + h * HD, BR + (size_t)b * SEQ * (3 * MIXW) + h * HD,
                        qb * 256, slope2, KMEAN + ((size_t)b * 8 + h) * 8 * HD);
    }
    SUBP_END(6)
    SUBP_BEGIN(7)
    for (bool first = true;; first = false) {
        int u; if (first) { __syncthreads(); u = F.bid; } else u = wq_pop(wq + 2 * 64, F.lds, F.wave) + F.G; if (u >= 8 * CHB * 8) break;
        const int qb = 7 - (u >> 6), b = (u & 63) >> 3, h = u & 7;
        const bf16_t* base = PROJ + (size_t)b * SEQ * QP;
        attn_unit_c(F.lds, F.wave, base + 6144 + h * HD, base + 7168 + h * HD, base + 8192 + h * HD, BR + (size_t)b * SEQ * (3 * MIXW) + 2 * MIXW + h * HD, qb * 256);
    }
    SUBP_END(7)
}
template <int N> __device__ __forceinline__ void halve_step(float (&v)[N], int m, int lane) {
    const bool up = (lane & m) != 0;
#pragma unroll
    for (int i = 0; i < N / 2; ++i) { const float lo = v[i], hi = v[i + N / 2]; const float keep = up ? hi : lo, send = up ? lo : hi; v[i] = keep + shx(send, m, lane); }
}
__device__ __forceinline__ void phase_router(const Frame& F0, KArgs a0, int layer) {
    Frame F = F0; F.tid = fresh_tid(F0.wave); F.lane = F.tid & 63; F.wave = __builtin_amdgcn_readfirstlane(F.tid >> 6); const KArgs a = fresh_args(a0); unsigned char* const ws_ = a->ws; F.ctl = (unsigned*)(ws_ + WS_CTL);
    unsigned char* H8 = ws_ + WS_H8;
    int* tok_e = (int*)(ws_ + WS_ROUT + RO_E); float* tok_w = (float*)(ws_ + WS_ROUT + RO_W);
    const float* gain = a->ffn_norm_g + layer * D; const float* wrg = a->w_rg + (size_t)layer * D * 4; const float* wre = a->w_re + (size_t)layer * D * NEXP;
    const bf16_t* xin = (const bf16_t*)(ws_ + WS_XB);
    constexpr int RT = 16, XP = 2 * D + 16, XBUF = RT * XP;
    constexpr int PA = 2 * XBUF, PB = 147456, PW = RT * 36 * 4;
    static_assert(PA + 4 * PW + 128 + 256 + 2048 <= 146432 - 256 && PB + 4 * PW <= LDS_BYTES, "router LDS");
    LAS unsigned char* lds = F.lds;
    LAS float* rs = (LAS float*)(lds + PA + 4 * PW);
    LAS int* myE = (LAS int*)(lds + PA + 4 * PW + 128 + 128);
    LAS float* mypart = (LAS float*)(lds + (F.wave < 4 ? PA + F.wave * PW : PB + (F.wave - 4) * PW));
    const int kq = F.lane >> 4, r16 = F.lane & 15;
    constexpr int NT = NTOK / RT;
    bf16x8 Bh[8][2], Bl[8][2];
#pragma unroll
    for (int s = 0; s < 8; ++s)
#pragma unroll
        for (int nb = 0; nb < 2; ++nb) {
            const int col = 16 * nb + r16; const int k0 = 256 * F.wave + 32 * s + 8 * kq;
            float wv[8];
#pragma unroll
            for (int e = 0; e < 8; ++e) { const int k = k0 + e; wv[e] = wre[(size_t)k * NEXP + col] * gain[k]; }
            u32x4 hw, lw;
#pragma unroll
            for (int e2 = 0; e2 < 4; ++e2) { const unsigned h = pk2(wv[2 * e2], wv[2 * e2 + 1]); hw[e2] = h; lw[e2] = pk2(wv[2 * e2] - bflo(h), wv[2 * e2 + 1] - bfhi(h)); }
            Bh[s][nb] = __builtin_bit_cast(bf16x8, hw); Bl[s][nb] = __builtin_bit_cast(bf16x8, lw);
        }
    __builtin_amdgcn_sched_barrier(0);
    auto dma_rows = [&](int tile_, int buf_) {
#pragma unroll
        for (int i = 0; i < 2; ++i) { const int r = 2 * F.wave + i; const bf16_t* src = xin + (size_t)(tile_ * RT + r) * D + F.lane * 8; LAS unsigned char* dst = lds + buf_ * XBUF + r * XP;
#pragma unroll
            for (int c = 0; c < 4; ++c) __builtin_amdgcn_global_load_lds((const unsigned*)(src + c * 512), (LAS unsigned*)(dst + c * 1024), 16, 0, 0); } };
    auto norm_rows = [&](int tile_, int buf_) {
        int ln = F.lane; asm volatile("" : "+v"(ln));
        const LAS u32x2* hr0 = (const LAS u32x2*)(lds + buf_ * XBUF + (2 * F.wave) * XP) + ln; const LAS u32x2* hr1 = (const LAS u32x2*)(lds + buf_ * XBUF + (2 * F.wave + 1) * XP) + ln;
        float s0 = 0.f, s1 = 0.f;
#pragma unroll
        for (int j = 0; j < 8; ++j) { const u32x2 t = hr0[64 * j], u = hr1[64 * j];
            { const float x0 = bflo(t.x), x1 = bfhi(t.x), x2 = bflo(t.y), x3 = bfhi(t.y); s0 += (x0 * x0 + x1 * x1) + (x2 * x2 + x3 * x3); }
            { const float x0 = bflo(u.x), x1 = bfhi(u.x), x2 = bflo(u.y), x3 = bfhi(u.y); s1 += (x0 * x0 + x1 * x1) + (x2 * x2 + x3 * x3); } }
        const float rstd0 = 1.0f / sqrtf(wave_sum(s0, ln) * (1.f / D) + RMS_EPS), rstd1 = 1.0f / sqrtf(wave_sum(s1, ln) * (1.f / D) + RMS_EPS);
        if (ln == 0) { rs[buf_ * RT + 2 * F.wave] = rstd0; rs[buf_ * RT + 2 * F.wave + 1] = rstd1; }
        unsigned* o80 = (unsigned*)(H8 + (size_t)(tile_ * RT + 2 * F.wave) * D) + ln; unsigned* o81 = o80 + D / 4;
#pragma unroll
        for (int hf = 0; hf < 2; ++hf) {
            f32x4 g[4];
#pragma unroll
            for (int j = 0; j < 4; ++j) g[j] = *((const f32x4*)gain + ln + 64 * (4 * hf + j));
#pragma unroll
            for (int j = 0; j < 4; ++j) { const u32x2 t = hr0[64 * (4 * hf + j)], u = hr1[64 * (4 * hf + j)];
                const f32x4 y0 = (f32x4){bflo(t.x), bfhi(t.x), bflo(t.y), bfhi(t.y)} * rstd0 * g[j], y1 = (f32x4){bflo(u.x), bfhi(u.x), bflo(u.y), bfhi(u.y)} * rstd1 * g[j];
                o80[64 * (4 * hf + j)] = pk4_fp8(y0.x, y0.y, y0.z, y0.w); o81[64 * (4 * hf + j)] = pk4_fp8(y1.x, y1.y, y1.z, y1.w); }
        } };
    int tile = F.bid;
    if (tile < NT) {
        dma_rows(tile, 0);
        if (tile + F.G < NT) { dma_rows(tile + F.G, 1); asm volatile("s_waitcnt vmcnt(8)" ::: "memory"); } else asm volatile("s_waitcnt vmcnt(0)" ::: "memory");
        norm_rows(tile, 0);
    }
    __syncthreads();
    f32x4 WG[4];
    { int lz = F.lane; asm volatile("" : "+v"(lz));
#pragma unroll
      for (int s = 0; s < 4; ++s) { const int k = 256 * F.wave + 64 * s + lz; WG[s] = *(const f32x4*)(wrg + (size_t)k * 4) * gain[k]; } }
    int buf = 0, it = 0;
    for (; tile < NT; tile += F.G, buf ^= 1, ++it) {
        {
            f32x4 acc[2];
#pragma unroll
            for (int nb = 0; nb < 2; ++nb) acc[nb] = (f32x4){0.f, 0.f, 0.f, 0.f};
            const LAS unsigned char* ap = lds + buf * XBUF + r16 * XP + (256 * F.wave + 8 * kq) * 2;
#pragma unroll
            for (int s = 0; s < 8; ++s) { const bf16x8 av = *(const LAS bf16x8*)(ap + s * 64);
#pragma unroll
                for (int nb = 0; nb < 2; ++nb) { acc[nb] = __builtin_amdgcn_mfma_f32_16x16x32_bf16(av, Bh[s][nb], acc[nb], 0, 0, 0); acc[nb] = __builtin_amdgcn_mfma_f32_16x16x32_bf16(av, Bl[s][nb], acc[nb], 0, 0, 0); } }
#pragma unroll
            for (int nb = 0; nb < 2; ++nb)
#pragma unroll
                for (int e = 0; e < 4; ++e) mypart[(4 * kq + e) * 36 + 4 + 16 * nb + r16] = acc[nb][e];
#pragma unroll
            for (int hv = 0; hv < 2; ++hv) {
                float gv[32];
#pragma unroll
                for (int i = 0; i < 32; ++i) gv[i] = 0.f;
                const LAS unsigned short* xp = (const LAS unsigned short*)(lds + buf * XBUF + (8 * hv) * XP) + 256 * F.wave + F.lane;
#pragma unroll
                for (int s = 0; s < 4; ++s) { const f32x4 wv = WG[s];
#pragma unroll
                    for (int t = 0; t < 8; ++t) { const float h = __uint_as_float((unsigned)xp[t * (XP / 2) + 64 * s] << 16); gv[4 * t] += h * wv.x; gv[4 * t + 1] += h * wv.y; gv[4 * t + 2] += h * wv.z; gv[4 * t + 3] += h * wv.w; } }
                halve_step<32>(gv, 32, F.lane); { float (&v16)[16] = *(float (*)[16])gv; halve_step<16>(v16, 16, F.lane); float (&v8)[8] = *(float (*)[8])gv; halve_step<8>(v8, 8, F.lane);
                    float (&v4)[4] = *(float (*)[4])gv; halve_step<4>(v4, 4, F.lane); float (&v2)[2] = *(float (*)[2])gv; halve_step<2>(v2, 2, F.lane); }
                { const float tot = gv[0] + shx(gv[0], 1, F.lane);
                  if ((F.lane & 1) == 0) mypart[(8 * hv + (F.lane >> 3)) * 36 + ((F.lane >> 1) & 3)] = tot; }
            }
        }
        if (tile + F.G < NT) { asm volatile("s_waitcnt vmcnt(0)" ::: "memory"); norm_rows(tile + F.G, buf ^ 1); }
        __syncthreads();
        if (tile + 2 * F.G < NT) dma_rows(tile + 2 * F.G, buf);
#pragma unroll
        for (int tt = 0; tt < 2; ++tt) {
            const int tok = 2 * F.wave + tt;
            float s = 0.f;
            if (F.lane < 36) {
#pragma unroll
                for (int w = 0; w < 8; ++w) s += *(const LAS float*)(lds + (w < 4 ? PA + w * PW : PB + (w - 4) * PW) + (tok * 36 + F.lane) * 4);
            }
            s *= rs[buf * RT + tok];
            const int si = __float_as_int(s);
            const float l0 = __int_as_float(__builtin_amdgcn_readlane(si, 0)), l1 = __int_as_float(__builtin_amdgcn_readlane(si, 1)), l2 = __int_as_float(__builtin_amdgcn_readlane(si, 2)), l3 = __int_as_float(__builtin_amdgcn_readlane(si, 3));
            int gi = 0; float gm = l0;
            if (l1 > gm) { gm = l1; gi = 1; }
            if (l2 > gm) { gm = l2; gi = 2; }
            if (l3 > gm) { gm = l3; gi = 3; }
            const float gz = ((expf(l0 - gm) + expf(l1 - gm)) + expf(l2 - gm)) + expf(l3 - gm);
            const float gtop = 1.0f / gz;
            const int eb = 4 + 8 * gi;
            float es[8];
#pragma unroll
            for (int q = 0; q < 8; ++q) es[q] = __int_as_float(__builtin_amdgcn_readlane(si, eb + q));
            int i0 = 0; float m0 = es[0];
#pragma unroll
            for (int q = 1; q < 8; ++q) { if (es[q] > m0) { m0 = es[q]; i0 = q; } }
            int i1 = -1; float m1 = -__builtin_inff();
#pragma unroll
            for (int q = 0; q < 8; ++q) { if (q != i0 && es[q] > m1) { m1 = es[q]; i1 = q; } }
            const float p1 = expf(m1 - m0);
            const float w0 = gtop / (1.0f + p1), w1 = gtop * p1 / (1.0f + p1);
            if (F.lane == 0) { const int m = tile * RT + tok; tok_e[2 * m] = gi * 8 + i0; tok_e[2 * m + 1] = gi * 8 + i1; tok_w[2 * m] = w0; tok_w[2 * m + 1] = w1;
                myE[it * 32 + 2 * tok] = gi * 8 + i0; myE[it * 32 + 2 * tok + 1] = gi * 8 + i1; }
        }
        __syncthreads();
    }
    asm volatile("s_waitcnt vmcnt(0)" ::: "memory");
    __syncthreads();
    {
        int* a_pos = (int*)(ws_ + WS_ROUT + RO_POS); unsigned* cnt = F.ctl + CW_CNT + layer * NEXP * 64;
        LAS unsigned* hist = (LAS unsigned*)F.lds; LAS unsigned* basev = hist + 32;
        const int nas = it * 32;
        for (int base = 0; base < nas; base += 256) {
            if (F.tid < 32) hist[F.tid] = 0u;
            __syncthreads();
            const int i = base + F.tid; const bool act = F.tid < 256 && i < nas;
            int e = 0; unsigned rank = 0u;
            if (act) { e = myE[i]; rank = __hip_atomic_fetch_add(hist + e, 1u, __ATOMIC_RELAXED, __HIP_MEMORY_SCOPE_WORKGROUP); }
            __syncthreads();
            if (F.tid < 32) { const unsigned h = hist[F.tid]; basev[F.tid] = h ? __hip_atomic_fetch_add(cnt + F.tid * 64, h, __ATOMIC_RELAXED, __HIP_MEMORY_SCOPE_AGENT) : 0u; }
            __syncthreads();
            if (act) { const int m = (F.bid + (i >> 5) * F.G) * RT + ((i & 31) >> 1); a_pos[2 * m + (i & 1)] = (int)(basev[e] + rank); }
            __syncthreads();
        }
    }
}
__device__ __forceinline__ void phase_scatter(const Frame& F0, KArgs a0, int layer) {
    Frame F = F0; F.tid = fresh_tid(F0.wave); F.lane = F.tid & 63; F.wave = __builtin_amdgcn_readfirstlane(F.tid >> 6); const KArgs a = fresh_args(a0); unsigned char* const ws_ = a->ws; F.ctl = (unsigned*)(ws_ + WS_CTL);
    const int* tok_e = (const int*)(ws_ + WS_ROUT + RO_E); const int* a_pos = (const int*)(ws_ + WS_ROUT + RO_POS); int* a_slot = (int*)(ws_ + WS_ROUT + RO_SLOT);
    int* tile_expert = (int*)(ws_ + WS_ROUT + RO_TILE); int* arow = (int*)(ws_ + WS_ROUT + RO_MAP);
    unsigned* cnt = F.ctl + CW_CNT + layer * NEXP * 64;
    LAS int* pstart = (LAS int*)F.lds; LAS int* pend = pstart + 32; LAS int* pcnt = pstart + 64;
    if (F.tid < NEXP) pcnt[F.tid] = (int)__hip_atomic_load(cnt + F.tid * 64, __ATOMIC_RELAXED, __HIP_MEMORY_SCOPE_AGENT);
    __syncthreads();
    if (F.tid == 0) { int run = 0;
        for (int e = 0; e < NEXP; ++e) { const int c = pcnt[e]; pstart[e] = run; run += ((c + 255) >> 8) << 8; pend[e] = run; } }
    __syncthreads();
    if (F.bid == 0 && F.tid <= MAXTILES) {
        const int ntiles = pend[NEXP - 1] >> 8;
        if (F.tid == MAXTILES) tile_expert[MAXTILES] = ntiles;
        else { int e = 0; for (int q = 0; q < NEXP; ++q) e += (pend[q] <= F.tid * 256) ? 1 : 0; tile_expert[F.tid] = e < NEXP ? e : NEXP - 1; }
    }
    if (F.bid < NEXP) {
        for (int s = pstart[F.bid] + pcnt[F.bid] + F.tid; s < pend[F.bid]; s += NTHR) arow[s] = 0;
    }
    for (int as = F.bid * NTHR + F.tid; as < NASSIGN; as += F.G * NTHR) {
        const int e = tok_e[as], slot = pstart[e] + a_pos[as];
        a_slot[as] = slot; arow[slot] = as >> 1;
    }
    __syncthreads();
}
__device__ __forceinline__ void phase_combine(const Frame& F0, KArgs a0, int layer) {
    Frame F = F0; F.tid = fresh_tid(F0.wave); F.lane = F.tid & 63; F.wave = __builtin_amdgcn_readfirstlane(F.tid >> 6); const KArgs a = fresh_args(a0); unsigned char* const ws_ = a->ws; F.ctl = (unsigned*)(ws_ + WS_CTL);
    const int* a_slot = (const int*)(ws_ + WS_ROUT + RO_SLOT); const float* tok_w = (const float*)(ws_ + WS_ROUT + RO_W);
    const bf16_t* Y = (const bf16_t*)(ws_ + WS_Y); bf16_t* H = (bf16_t*)(ws_ + WS_H); bf16_t* XB = (bf16_t*)(ws_ + WS_XB);
    const int gw = F.bid * NWAVES + F.wave, NGW = F.G * NWAVES;
    for (int mb = gw; mb < NTOK; mb += 2 * NGW) {
        f32x4 v[2][8];
#pragma unroll
        for (int q = 0; q < 2; ++q) { const int m = (mb + q * NGW < NTOK) ? mb + q * NGW : mb;
            const int s0 = a_slot[2 * m], s1 = a_slot[2 * m + 1]; const float w0 = tok_w[2 * m], w1 = tok_w[2 * m + 1];
            const u32x2* xr = (const u32x2*)(XB + (size_t)m * D) + F.lane;
            const u32x2* y0 = (const u32x2*)(Y + (size_t)s0 * D) + F.lane; const u32x2* y1 = (const u32x2*)(Y + (size_t)s1 * D) + F.lane;
#pragma unroll
            for (int j = 0; j < 8; ++j) { const u32x2 xw_ = xr[64 * j]; const f32x4 x = {bflo(xw_.x), bfhi(xw_.x), bflo(xw_.y), bfhi(xw_.y)}; const u32x2 p = __builtin_nontemporal_load(y0 + 64 * j), r = __builtin_nontemporal_load(y1 + 64 * j);
                f32x4 c; c.x = w0 * bflo(p.x) + w1 * bflo(r.x); c.y = w0 * bfhi(p.x) + w1 * bfhi(r.x); c.z = w0 * bflo(p.y) + w1 * bflo(r.y); c.w = w0 * bfhi(p.y) + w1 * bfhi(r.y);
                v[q][j] = x + c; } }
#pragma unroll
        for (int q = 0; q < 2; ++q) { const int m = mb + q * NGW; if (m < NTOK) {
            if (layer + 1 < DEPTH) {
                u32x2* xw = (u32x2*)(XB + (size_t)m * D) + F.lane;
#pragma unroll
                for (int j = 0; j < 8; ++j) { u32x2 o; o.x = pk2(v[q][j].x, v[q][j].y); o.y = pk2(v[q][j].z, v[q][j].w); xw[64 * j] = o; }
                rms_row_to_fp8(v[q], a->attn_norm_g + (layer + 1) * D, ws_ + WS_H8 + (size_t)m * D, (float*)(ws_ + WS_RSTD) + m, F.lane);
            } else {
                f32x4* xw = (f32x4*)(a->out + (size_t)m * D) + F.lane;
#pragma unroll
                for (int j = 0; j < 8; ++j) __builtin_nontemporal_store(v[q][j], xw + 64 * j);
            } } }
    }
}

constexpr int NSTEPS = 1 + DEPTH * (NCH * 2 + 2 + 5);
__global__ void __launch_bounds__(NTHR, 2) mega_fwd(Args a_unused) {
    const KArgs a = (KArgs)__builtin_amdgcn_kernarg_segment_ptr();
    extern __shared__ __attribute__((aligned(16))) unsigned char lds_raw[];
    Frame F;
    F.lds = (LAS unsigned char*)lds_raw; F.MISC = (volatile LAS unsigned*)(F.lds + MISC_OFF);
    F.wave = __builtin_amdgcn_readfirstlane((int)threadIdx.x >> 6); F.tid = fresh_tid(F.wave); F.lane = F.tid & 63; F.G = gridDim.x; F.bid = blockIdx.x;
    F.ctl = (unsigned*)(a->ws + WS_CTL);
    for (int u = F.tid; u < 256; u += NTHR) ((LAS unsigned*)(F.lds + MISC_OFF))[u] = 0u;
    __syncthreads();
    const int lo = a->step_lo, hi = a->step_hi;
    XcdBarrier bar; bar.bar = F.ctl + CW_BAR; bar.x = 0; bar.st = nullptr; bar.wave = F.wave;
    if (hi - lo > 1) bar = xcd_barrier_post(F.ctl + CW_BAR, F.MISC + 8, F.wave);
    int step = 0;
#ifdef PROBE_MASK
    unsigned long long tacc = 0ull, tph = 0ull;
#define PHASE_BEGIN if (step >= lo && step < hi) { tph = __builtin_amdgcn_s_memrealtime();
#ifndef PROBE_BAR
#define PROBE_BAR 0
#endif
#define PHASE_END(cat)   { const unsigned long long tb_ = __builtin_amdgcn_s_memrealtime(); if (step + 1 < hi) xcd_barrier(bar); const unsigned long long te_ = __builtin_amdgcn_s_memrealtime(); if ((PROBE_MASK >> (cat)) & 1) tacc += te_ - tph; if ((PROBE_BAR >> (cat)) & 1) tacc += te_ - tb_; } } ++step;
#else
#define PHASE_BEGIN if (step >= lo && step < hi) {
#define PHASE_END(cat)   if (step + 1 < hi) xcd_barrier(bar); } ++step;
#endif

    PHASE_BEGIN phase_norm0(F, a); phase_wconv(F, a, 0); __syncthreads(); PHASE_END(0)

    for (int layer = 0; layer < DEPTH; ++layer) {
        for (int chunk = 0; chunk < NCH; ++chunk) {
            PHASE_BEGIN {
                unsigned char* const ws = fresh_args(a)->ws; bf16_t* H = (bf16_t*)(ws + WS_H); bf16_t* PROJ = (bf16_t*)(ws + WS_PROJ); const bf16_t* win_t = (const bf16_t*)(ws + WS_WIN);
                const KArgs ka = fresh_args(a);
                const size_t gofs = (WS_GATES - WS_PROJ) + (size_t)chunk * CHT * GP;
                { pg8::Gemm g{(const bf16_t*)(ws + WS_XB) + (size_t)chunk * CHT * D, win_t, D, D, D, 0};     pg8::StaticOrder S; int bid_ = F.bid, G_ = F.G; asm volatile("" : "+s"(bid_), "+s"(G_)); S.init(CHT, 4 * MIXW, G_, bid_);
                  pg8::EpiProj E{PROJ, ka->gate_bias + (size_t)layer * 3 * D, ka->moba_q_gain + layer * HD, ka->moba_k_gain + layer * HD, ka->diff_q_gain + layer * HD, ka->diff_k_gain + layer * HD, (float*)(ws + WS_KMEAN), F.lds + XTRA_OFF, 0x8543ull, gofs, (const float*)(ws + WS_RSTD) + (size_t)chunk * CHT};
                  pg8::gemm_phase<pg8::EpiProj, pg8::StaticOrder, true>(F.lds, g, S, E, F.wave); }
                {
                  pg8::Gemm g{(const bf16_t*)(ws + WS_H8 + (size_t)chunk * CHT * D), (const bf16_t*)(ws + WS_WIN8), D / 2, D / 2, D / 2, 0}; pg8::StaticOrder S; int bid_ = F.bid, G_ = F.G; asm volatile("" : "+s"(bid_), "+s"(G_)); S.init(CHT, 11 * MIXW, G_, bid_);
                  pg8::EpiProj E{PROJ, ka->gate_bias + (size_t)layer * 3 * D, ka->moba_q_gain + layer * HD, ka->moba_k_gain + layer * HD, ka->diff_q_gain + layer * HD, ka->diff_k_gain + layer * HD, (float*)(ws + WS_KMEAN), F.lds + XTRA_OFF, 0xEDCBA976210ull, gofs, nullptr};
                  pg8::gemm_phase<pg8::EpiProj, pg8::StaticOrder, true, true>(F.lds, g, S, E, F.wave); }
            } PHASE_END(1)
            PHASE_BEGIN phase_attn(F, a, layer, chunk); PHASE_END(3)
        }
        {
            PHASE_BEGIN {
                unsigned char* const ws = fresh_args(a)->ws; const unsigned char* GATES = ws + WS_GATES; bf16_t* BR = (bf16_t*)(ws + WS_BR); bf16_t* MIXB = (bf16_t*)(ws + WS_MIXB); const bf16_t* wbr_t = (const bf16_t*)(ws + WS_WBR);
                pg8::Gemm g{BR, wbr_t, 3 * MIXW, MIXW, MIXW, (size_t)D * MIXW, (size_t)MIXW}; pg8::ChainOrder S; int bid_ = F.bid, G_ = F.G; asm volatile("" : "+s"(bid_), "+s"(G_)); S.init(NTOK, D, G_, bid_); S.nb = 3;
                pg8::EpiGateChain E{GATES, MIXB};
                pg8::gemm_phase<pg8::EpiGateChain, pg8::ChainOrder, true>(F.lds, g, S, E, F.wave);
            } PHASE_END(4)
            PHASE_BEGIN {
                unsigned char* const ws = fresh_args(a)->ws; bf16_t* MIXB = (bf16_t*)(ws + WS_MIXB); const bf16_t* wout_t = (const bf16_t*)(ws + WS_WOUT);
                pg8::Gemm g{MIXB, wout_t, D, D, D, 0}; pg8::StaticOrder S; int bid_ = F.bid, G_ = F.G; asm volatile("" : "+s"(bid_), "+s"(G_)); S.init(NTOK, D, G_, bid_);
                pg8::EpiResid E{(bf16_t*)(ws + WS_XB)};
                pg8::gemm_phase<pg8::EpiResid, pg8::StaticOrder, true>(F.lds, g, S, E, F.wave);
            } PHASE_END(5)
        }
        PHASE_BEGIN phase_router(F, a, layer); PHASE_END(6)
        PHASE_BEGIN phase_scatter(F, a, layer); PHASE_END(8)
        PHASE_BEGIN {
            unsigned char* const ws = fresh_args(a)->ws; unsigned char* ACT = ws + WS_ACT; const bf16_t* wgu_t = (const bf16_t*)(ws + WS_WGU); const int* tile_expert = (const int*)(ws + WS_ROUT + RO_TILE);
            const int ntiles = __builtin_amdgcn_readfirstlane(tile_expert[MAXTILES]);
            pg8::Gemm g{(const bf16_t*)(ws + WS_H8), wgu_t, D / 2, D / 2, D / 2, (size_t)2 * FF * D / 2, 0, (const int*)(ws + WS_ROUT + RO_MAP)}; pg8::MoeOrder S; int bid_ = F.bid, G_ = F.G; asm volatile("" : "+s"(bid_), "+s"(G_)); S.init(ntiles * 256, 2 * FF, G_, bid_); S.tile_expert = tile_expert;
            pg8::EpiSwiglu E{ACT};
            pg8::gemm_phase<pg8::EpiSwiglu, pg8::MoeOrder, true, true, true>(F.lds, g, S, E, F.wave);
            if (layer + 1 < DEPTH) {
                const int rem = (ntiles * 4) % F.G; const bool part = rem != 0 && rem <= F.G / 2;
                __syncthreads(); phase_wconv(F, a, layer + 1, 0, WC_I_IN, part ? rem : 0, part ? F.G - rem : F.G); __syncthreads();
            }
        } PHASE_END(9)
        PHASE_BEGIN {
            unsigned char* const ws = fresh_args(a)->ws; const bf16_t* ACT = (const bf16_t*)(ws + WS_ACT); bf16_t* Y = (bf16_t*)(ws + WS_Y); const bf16_t* wd_t = (const bf16_t*)(ws + WS_WD); const int* tile_expert = (const int*)(ws + WS_ROUT + RO_TILE);
            const int ntiles = __builtin_amdgcn_readfirstlane(tile_expert[MAXTILES]);
            pg8::Gemm g{ACT, wd_t, FF / 2, FF / 2, FF / 2, (size_t)D * FF / 2};     pg8::MoeOrder S; int bid_ = F.bid, G_ = F.G; asm volatile("" : "+s"(bid_), "+s"(G_)); S.init(ntiles * 256, D, G_, bid_); S.tile_expert = tile_expert;
            pg8::EpiBf16Plain E{Y, D};
            pg8::gemm_phase<pg8::EpiBf16Plain, pg8::MoeOrder, true, true, false, 0x00007b79>(F.lds, g, S, E, F.wave);
        } PHASE_END(10)
        PHASE_BEGIN phase_combine(F, a, layer); if (layer + 1 < DEPTH) { phase_wconv(F, a, layer + 1, WC_I_IN, WC_NITEMS); __syncthreads(); } PHASE_END(11)
    }
#ifdef PROBE_MASK
    if (blockIdx.x == 0 && is_thread0(F.wave)) { const unsigned long long t0 = __builtin_amdgcn_s_memrealtime(); unsigned long long tt = tacc;
#if defined(PROBE_SUB) || defined(PROBE_EPI)
        tt += F.MISC[16];
#endif
        while (__builtin_amdgcn_s_memrealtime() - t0 < tt) __builtin_amdgcn_s_sleep(16); }
#endif
#undef PHASE_BEGIN
#undef PHASE_END
}

extern "C" void kernel_launch(void* const* d_in, const int* in_sizes, int n_in, void* d_out, int out_size, void* d_ws, size_t ws_size, hipStream_t stream) {
    static int grid = 0;
    if (grid == 0) {
        if (n_in != 21 || in_sizes[0] != NTOK * D || out_size != NTOK * D || ws_size < WS_END) { fprintf(stderr, "kernel_launch: unexpected shapes (n_in %d, in0 %d, out %d, ws %zu); nothing launched\n", n_in, n_in > 0 ? in_sizes[0] : -1, out_size, ws_size); grid = -1; return; }
        int dev = 0, cus = 0, per_cu = 0;
        if (hipGetDevice(&dev) != hipSuccess || hipDeviceGetAttribute(&cus, hipDeviceAttributeMultiprocessorCount, dev) != hipSuccess) { grid = -1; return; }
        if (hipFuncSetAttribute((const void*)mega_fwd, hipFuncAttributeMaxDynamicSharedMemorySize, LDS_BYTES) != hipSuccess) { fprintf(stderr, "kernel_launch: hipFuncSetAttribute failed\n"); grid = -1; return; }
        if (hipOccupancyMaxActiveBlocksPerMultiprocessor(&per_cu, (const void*)mega_fwd, NTHR, LDS_BYTES) != hipSuccess || per_cu < 1) fprintf(stderr, "kernel_launch: occupancy query reports %d blocks per CU\n", per_cu);
        (void)hipGetLastError();
        grid = cus;
        if (grid < 128 || grid > 1024) { fprintf(stderr, "kernel_launch: unexpected CU count %d; nothing launched\n", grid); grid = -1; return; }
    }
    if (grid < 0) return;
    (void)hipMemsetAsync((char*)d_ws + WS_CTL, 0, (size_t)32 * MiB, stream);
    Args a{};
    a.x = (const float*)d_in[0]; a.attn_norm_g = (const float*)d_in[1]; a.w_in = (const float*)d_in[2]; a.gate_bias = (const float*)d_in[3];
    a.moba_q_gain = (const float*)d_in[4]; a.moba_k_gain = (const float*)d_in[5]; a.diff_q_gain = (const float*)d_in[6]; a.diff_k_gain = (const float*)d_in[7];
    a.lq1 = (const float*)d_in[8]; a.lk1 = (const float*)d_in[9]; a.lq2 = (const float*)d_in[10]; a.lk2 = (const float*)d_in[11]; a.diff_head_gain = (const float*)d_in[12];
    a.w_branch = (const float*)d_in[13]; a.w_out = (const float*)d_in[14]; a.ffn_norm_g = (const float*)d_in[15]; a.w_rg = (const float*)d_in[16]; a.w_re = (const float*)d_in[17];
    a.w_eg = (const float*)d_in[18]; a.w_eu = (const float*)d_in[19]; a.w_ed = (const float*)d_in[20];
    a.out = (float*)d_out; a.ws = (unsigned char*)d_ws;
#ifndef MK_SPLIT
    a.step_lo = 0; a.step_hi = NSTEPS;
    hipLaunchKernelGGL(mega_fwd, dim3(grid), dim3(NTHR), LDS_BYTES, stream, a);
#else
    for (int s = 0; s < NSTEPS; ++s) { a.step_lo = s; a.step_hi = s + 1; hipLaunchKernelGGL(mega_fwd, dim3(grid), dim3(NTHR), LDS_BYTES, stream, a); }
#endif
}
```
